# Optimizing an MI355X kernel written in HIP

```python
import jax, jax.numpy as jnp
from jax import lax
import numpy as np

D_MODEL = 2048
BATCH = 8
SEQ = 2048
DEPTH = 1

MLA_HEADS = 16
MLA_Q_LORA = 512
MLA_KV_LORA = 512
MLA_NOPE_DIM = 128
MLA_ROPE_DIM = 64
MLA_V_DIM = 128
ROPE_THETA = 10000.0
Q_BLOCK = 128
HGRN_HEADS = 16
HGRN_EXPAND = 128
HGRN_HEAD_DIM = D_MODEL // HGRN_HEADS
HGRN_CHUNK = 64
D_FF = 5632
MACARON_SCALE = 0.5
NORM_EPS = 1e-6

MLA_WIDTH = MLA_HEADS * MLA_V_DIM
HGRN_KEY_WIDTH = HGRN_HEADS * HGRN_EXPAND
HGRN_VAL_WIDTH = HGRN_HEADS * HGRN_HEAD_DIM
IN_SPLITS = (MLA_Q_LORA, MLA_KV_LORA, MLA_ROPE_DIM, HGRN_KEY_WIDTH, HGRN_KEY_WIDTH,
             HGRN_VAL_WIDTH, HGRN_VAL_WIDTH, D_MODEL, D_MODEL)
IN_COLS = 13376

kernel_name = "hybrid_mla_hgrn2_macaron_sandwich"


def rmsnorm(x, w):
    x32 = x.astype(jnp.float32)
    y = x32 * lax.rsqrt(jnp.mean(x32 * x32, axis=-1, keepdims=True) + NORM_EPS)
    return (y * w.astype(jnp.float32)).astype(x.dtype)


def swiglu(h, w_gate, w_up, w_down):
    return (jax.nn.silu(h @ w_gate) * (h @ w_up)) @ w_down


def rope(t, cos, sin):
    half = t.shape[-1] // 2
    t1, t2 = t[..., :half], t[..., half:]
    return jnp.concatenate([t1 * cos - t2 * sin, t1 * sin + t2 * cos], axis=-1).astype(t.dtype)


def split_columns(proj):
    parts, start = [], 0
    for width in IN_SPLITS:
        parts.append(proj[..., start:start + width])
        start += width
    return parts


def mla_branch(c_q, c_kv, k_rope, positions, q_norm, w_q_up, kv_norm, w_kv_up, w_o):
    B, S, _ = c_q.shape
    q = (rmsnorm(c_q, q_norm) @ w_q_up).reshape(B, S, MLA_HEADS, MLA_NOPE_DIM + MLA_ROPE_DIM)
    q_nope, q_rope = q[..., :MLA_NOPE_DIM], q[..., MLA_NOPE_DIM:]
    kv = (rmsnorm(c_kv, kv_norm) @ w_kv_up).reshape(B, S, MLA_HEADS, MLA_NOPE_DIM + MLA_V_DIM)
    k_nope, v = kv[..., :MLA_NOPE_DIM], kv[..., MLA_NOPE_DIM:]
    half = MLA_ROPE_DIM // 2
    inv_freq = ROPE_THETA ** (-jnp.arange(half, dtype=jnp.float32) / half)
    ang = positions.astype(jnp.float32)[..., None] * inv_freq
    cos, sin = jnp.cos(ang), jnp.sin(ang)
    q_rope = rope(q_rope, cos[:, :, None, :], sin[:, :, None, :])
    k_rope = rope(k_rope, cos, sin)
    scale = (MLA_NOPE_DIM + MLA_ROPE_DIM) ** -0.5
    nb = S // Q_BLOCK
    key_idx = jnp.arange(S)

    def blocks(t):
        return t.reshape((B, nb, Q_BLOCK) + t.shape[2:]).swapaxes(0, 1)

    def attend(args):
        qn, qr, blk = args
        q_idx = blk * Q_BLOCK + jnp.arange(Q_BLOCK)
        s = (jnp.einsum('bqhd,bkhd->bhqk', qn, k_nope)
             + jnp.einsum('bqhr,bkr->bhqk', qr, k_rope)).astype(jnp.float32) * scale
        s = jnp.where(key_idx[None, :] <= q_idx[:, None], s, -jnp.inf)
        p = jax.nn.softmax(s, axis=-1).astype(v.dtype)
        return jnp.einsum('bhqk,bkhd->bqhd', p, v)

    o = lax.map(attend, (blocks(q_nope), blocks(q_rope), jnp.arange(nb)))
    o = o.swapaxes(0, 1).reshape(B, S, MLA_WIDTH)
    return o @ w_o


def hgrn2_branch(hq, hf, hi, hg, lower_bound, out_norm, w_o):
    B, S, _ = hq.shape
    C = HGRN_CHUNK
    nc = S // C

    def heads(t, d):
        return t.reshape(B, S, HGRN_HEADS, d).transpose(0, 2, 1, 3).astype(jnp.float32)

    q = heads(jax.nn.silu(hq), HGRN_EXPAND)
    lb = lower_bound.astype(jnp.float32)
    f_gate = lb + (1.0 - lb) * jax.nn.sigmoid(hf.astype(jnp.float32))
    k = heads(1.0 - f_gate, HGRN_EXPAND)
    log_f = heads(jnp.log(f_gate), HGRN_EXPAND)
    v = heads(hi, HGRN_HEAD_DIM)

    def chunks(t):
        return t.reshape(B, HGRN_HEADS, nc, C, t.shape[-1]).transpose(2, 0, 1, 3, 4)

    causal = jnp.tril(jnp.ones((C, C), dtype=bool))

    def step(state, inp):
        qc, kc, vc, gc = inp
        b = jnp.cumsum(gc, axis=2)
        inter = jnp.einsum('bhtk,bhkv->bhtv', qc * jnp.exp(b), state)
        diff = b[:, :, :, None, :] - b[:, :, None, :, :]
        decay = jnp.exp(jnp.where(causal[:, :, None], diff, -jnp.inf))
        scores = jnp.einsum('bhtk,bhtsk,bhsk->bhts', qc, decay, kc)
        intra = jnp.einsum('bhts,bhsv->bhtv', scores, vc)
        b_last = b[:, :, -1:, :]
        new_state = (jnp.exp(b_last[:, :, 0, :])[..., None] * state
                     + jnp.einsum('bhsk,bhsv->bhkv', kc * jnp.exp(b_last - b), vc))
        return new_state, inter + intra

    s0 = jnp.zeros((B, HGRN_HEADS, HGRN_EXPAND, HGRN_HEAD_DIM), jnp.float32)
    _, o = lax.scan(step, s0, (chunks(q), chunks(k), chunks(v), chunks(log_f)))
    o = o.transpose(1, 0, 3, 2, 4).reshape(B, S, HGRN_HEADS, HGRN_HEAD_DIM)
    o = rmsnorm(o, out_norm) * jax.nn.silu(hg.reshape(B, S, HGRN_HEADS, HGRN_HEAD_DIM).astype(jnp.float32))
    return o.reshape(B, S, HGRN_VAL_WIDTH).astype(hq.dtype) @ w_o


def token_mixer(h, positions, w_in, mla_q_norm, mla_w_q_up, mla_kv_norm, mla_w_kv_up, mla_w_o,
                lower_bound, hgrn_out_norm, hgrn_w_o, w_out):
    proj = h @ w_in
    c_q, c_kv, k_rope, hq, hf, hi, hg, gate_a, gate_b = split_columns(proj)
    y_a = mla_branch(c_q, c_kv, k_rope, positions, mla_q_norm, mla_w_q_up, mla_kv_norm, mla_w_kv_up, mla_w_o)
    y_b = hgrn2_branch(hq, hf, hi, hg, lower_bound, hgrn_out_norm, hgrn_w_o)
    merged = jax.nn.sigmoid(gate_a) * y_a + jax.nn.sigmoid(gate_b) * y_b
    return merged @ w_out


def setup_inputs(seed: int = 0) -> dict:
    key = jax.random.key(seed)
    ks = jax.random.split(key, 28)

    def w(k, shape, fan_in):
        return jax.random.normal(k, shape, jnp.float32) * (fan_in ** -0.5)

    def gain(k, shape):
        return 1.0 + 0.05 * jax.random.normal(k, shape, jnp.float32)

    x = jax.random.normal(ks[0], (BATCH, SEQ, D_MODEL), jnp.float32)
    offsets = jax.random.randint(ks[1], (BATCH, 1), 0, 4096, dtype=jnp.int32)
    positions = offsets + jnp.arange(SEQ, dtype=jnp.int32)[None, :]
    return {
        "x": x,
        "positions": positions,
        "ffn1_norm_pre": gain(ks[2], (DEPTH, D_MODEL)),
        "ffn1_w_gate": w(ks[3], (DEPTH, D_MODEL, D_FF), D_MODEL),
        "ffn1_w_up": w(ks[4], (DEPTH, D_MODEL, D_FF), D_MODEL),
        "ffn1_w_down": w(ks[5], (DEPTH, D_FF, D_MODEL), D_FF),
        "ffn1_norm_post": gain(ks[6], (DEPTH, D_MODEL)),
        "mix_norm_pre": gain(ks[7], (DEPTH, D_MODEL)),
        "w_in": w(ks[8], (DEPTH, D_MODEL, IN_COLS), D_MODEL),
        "mla_q_norm": gain(ks[9], (DEPTH, MLA_Q_LORA)),
        "mla_w_q_up": w(ks[10], (DEPTH, MLA_Q_LORA, MLA_HEADS * (MLA_NOPE_DIM + MLA_ROPE_DIM)), MLA_Q_LORA),
        "mla_kv_norm": gain(ks[11], (DEPTH, MLA_KV_LORA)),
        "mla_w_kv_up": w(ks[12], (DEPTH, MLA_KV_LORA, MLA_HEADS * (MLA_NOPE_DIM + MLA_V_DIM)), MLA_KV_LORA),
        "mla_w_o": w(ks[13], (DEPTH, MLA_WIDTH, D_MODEL), MLA_WIDTH),
        "hgrn_lb_logits": 0.5 * jax.random.normal(ks[14], (DEPTH + 1, HGRN_KEY_WIDTH), jnp.float32),
        "hgrn_out_norm": gain(ks[15], (DEPTH, HGRN_HEAD_DIM)),
        "hgrn_w_o": w(ks[16], (DEPTH, HGRN_VAL_WIDTH, D_MODEL), HGRN_VAL_WIDTH),
        "w_out": w(ks[17], (DEPTH, D_MODEL, D_MODEL), D_MODEL),
        "mix_norm_post": gain(ks[18], (DEPTH, D_MODEL)),
        "ffn2_norm_pre": gain(ks[19], (DEPTH, D_MODEL)),
        "ffn2_w_gate": w(ks[20], (DEPTH, D_MODEL, D_FF), D_MODEL),
        "ffn2_w_up": w(ks[21], (DEPTH, D_MODEL, D_FF), D_MODEL),
        "ffn2_w_down": w(ks[22], (DEPTH, D_FF, D_MODEL), D_FF),
        "ffn2_norm_post": gain(ks[23], (DEPTH, D_MODEL)),
    }


def reference(x, positions, ffn1_norm_pre, ffn1_w_gate, ffn1_w_up, ffn1_w_down, ffn1_norm_post,
              mix_norm_pre, w_in, mla_q_norm, mla_w_q_up, mla_kv_norm, mla_w_kv_up, mla_w_o,
              hgrn_lb_logits, hgrn_out_norm, hgrn_w_o, w_out, mix_norm_post,
              ffn2_norm_pre, ffn2_w_gate, ffn2_w_up, ffn2_w_down, ffn2_norm_post):
    lb_table = jnp.cumsum(jax.nn.softmax(hgrn_lb_logits.astype(jnp.float32), axis=0), axis=0)
    for l in range(DEPTH):
        h = rmsnorm(x, ffn1_norm_pre[l])
        x = x + MACARON_SCALE * rmsnorm(swiglu(h, ffn1_w_gate[l], ffn1_w_up[l], ffn1_w_down[l]), ffn1_norm_post[l])
        h = rmsnorm(x, mix_norm_pre[l])
        y = token_mixer(h, positions, w_in[l], mla_q_norm[l], mla_w_q_up[l], mla_kv_norm[l], mla_w_kv_up[l],
                        mla_w_o[l], lb_table[l], hgrn_out_norm[l], hgrn_w_o[l], w_out[l])
        x = x + rmsnorm(y, mix_norm_post[l])
        h = rmsnorm(x, ffn2_norm_pre[l])
        x = x + MACARON_SCALE * rmsnorm(swiglu(h, ffn2_w_gate[l], ffn2_w_up[l], ffn2_w_down[l]), ffn2_norm_post[l])
    return x
```

```cpp
#include <hip/hip_runtime.h>
#include <hip/hip_cooperative_groups.h>
#include <cstdio>
#include <cstdint>
namespace cg = cooperative_groups;
namespace pg8 {
#define PG8_LAS __attribute__((address_space(3)))
typedef unsigned short bf16_t;
typedef short bf16x8 __attribute__((ext_vector_type(8)));
typedef float f32x4 __attribute__((ext_vector_type(4)));
typedef unsigned u32x4 __attribute__((ext_vector_type(4)));
constexpr int BM = 256, BK = 64, HALF = 128, HTB = HALF * BK * 2  , STAGE_BYTES = 8 * HTB, NXCD = 8, WGM = 8;

__host__ __device__ __forceinline__ int lds_byte(int r, int c) { const int st = (r >> 4) * 2 + (c >> 5), rr = r & 15, cc = c & 31, ob = rr * 64 + cc * 2; return st * 1024 + (ob ^ (((ob >> 9) & 1) << 5)); }
__host__ __device__ __forceinline__ void stage_rc(int b, int& R, int& C) { const int st = b / 1024, sb = b % 1024, swz = sb ^ (((sb >> 9) & 1) << 5); R = (st >> 1) * 16 + swz / 64; C = (st & 1) * 32 + (swz % 64) / 2; }
__host__ __device__ __forceinline__ int perm32(int rho) { const int n = rho >> 4, i = rho & 15; return 8 * (i >> 2) + 4 * n + (i & 3); }

struct Unit { int pm, pn; };
struct Gemm { const bf16_t* A; const bf16_t* Bt; int M, N, K; };

struct StaticOrder {
    int nM, nN, nwg, G, c;
    __host__ __device__ void init(int M, int N, int G_, int c_) { nM = M / BM; nN = N / BM; nwg = nM * nN; G = G_; c = c_; }
    __host__ __device__ bool next(int i, Unit& u) const {
        const long L = (long)i * G + c; if (L >= nwg) return false;
        int wgid = (int)L; { const int q = nwg / NXCD, r = nwg % NXCD, xcd = wgid % NXCD, off = wgid / NXCD; wgid = (xcd < r ? xcd * (q + 1) : r * (q + 1) + (xcd - r) * q) + off; }
        const int nig = WGM * nN, gid = wgid / nig, fm = gid * WGM, gsz = (nM - fm) < WGM ? (nM - fm) : WGM;
        u.pm = fm + ((wgid % nig) % gsz); u.pn = (wgid % nig) / gsz; return true;
    }
    __device__ __forceinline__ void a_ready(const Unit&) const {}
    __device__ __forceinline__ void done(const Unit&) const {}
};

__device__ __forceinline__ unsigned cvt_pk_bf16(float lo, float hi) { unsigned r; asm volatile("v_cvt_pk_bf16_f32 %0, %1, %2" : "=v"(r) : "v"(lo), "v"(hi)); return r; }
typedef unsigned u32x2 __attribute__((ext_vector_type(2)));
__device__ __forceinline__ float fsigmoid(float x) { return __builtin_amdgcn_rcpf(1.0f + __expf(-x)); }
__device__ __forceinline__ float fsilu(float x) { return x * __builtin_amdgcn_rcpf(1.0f + __expf(-x)); }
__device__ __forceinline__ float bf_lo(unsigned u) { return __uint_as_float(u << 16); }
__device__ __forceinline__ float bf_hi(unsigned u) { return __uint_as_float(u & 0xffff0000u); }
typedef float f32x2c __attribute__((ext_vector_type(2))); typedef __bf16 bf16x2c __attribute__((ext_vector_type(2)));
__device__ __forceinline__ unsigned cvt2(float lo, float hi) { f32x2c v = {lo, hi}; bf16x2c b = __builtin_convertvector(v, bf16x2c); return __builtin_bit_cast(unsigned, b); }
__device__ __forceinline__ u32x4 pack8(const f32x4 v0, const f32x4 v1) { u32x4 w; w.x = cvt2(v0[0], v0[1]); w.y = cvt2(v0[2], v0[3]); w.z = cvt2(v1[0], v1[1]); w.w = cvt2(v1[2], v1[3]); return w; }
__device__ __forceinline__ void unpack8(const u32x4 w, f32x4& v0, f32x4& v1) { v0 = (f32x4){bf_lo(w.x), bf_hi(w.x), bf_lo(w.y), bf_hi(w.y)}; v1 = (f32x4){bf_lo(w.z), bf_hi(w.z), bf_lo(w.w), bf_hi(w.w)}; }

struct EpiSwiGLU {
    static constexpr bool PERM = true, AFTER_DRAIN = false;
    bf16_t* O; int ldc;
    __device__ __forceinline__ void operator()(const f32x4 (&acc)[2][2][4][2], const Unit& u, int wr, int wc, int fr, int fq) const {
        const int row0 = u.pm * BM + wr * 64 + fr, col0 = u.pn * 128 + wc * 32 + 8 * fq;
#pragma unroll
        for (int ai = 0; ai < 2; ++ai)
#pragma unroll
            for (int m = 0; m < 4; ++m) {
                f32x4 v0, v1;
#pragma unroll
                for (int e = 0; e < 4; ++e) { v0[e] = fsilu(acc[ai][0][m][0][e]) * acc[ai][1][m][0][e]; v1[e] = fsilu(acc[ai][0][m][1][e]) * acc[ai][1][m][1][e]; }
                *(u32x4*)(O + (size_t)(row0 + ai * HALF + m * 16) * ldc + col0) = pack8(v0, v1);
            }
    }
};
struct EpiF32 {
    static constexpr bool PERM = false, AFTER_DRAIN = false;
    float* C; int ldc;
    __device__ __forceinline__ void operator()(const f32x4 (&acc)[2][2][4][2], const Unit& u, int wr, int wc, int fr, int fq) const {
        const int row0 = u.pm * BM + wr * 64 + fr, col0 = u.pn * BM + wc * 32 + 4 * fq;
#pragma unroll
        for (int ai = 0; ai < 2; ++ai)
#pragma unroll
            for (int m = 0; m < 4; ++m) { float* rowp = C + (size_t)(row0 + ai * HALF + m * 16) * ldc + col0;
#pragma unroll
                for (int bj = 0; bj < 2; ++bj)
#pragma unroll
                    for (int n = 0; n < 2; ++n) *(f32x4*)(rowp + bj * HALF + n * 16) = acc[ai][bj][m][n]; }
    }
};
struct EpiBf {
    static constexpr bool PERM = true, AFTER_DRAIN = false;
    bf16_t* O; int ldc;
    __device__ __forceinline__ void operator()(const f32x4 (&acc)[2][2][4][2], const Unit& u, int wr, int wc, int fr, int fq) const {
        const int row0 = u.pm * BM + wr * 64 + fr, col0 = u.pn * BM + wc * 32 + 8 * fq;
#pragma unroll
        for (int ai = 0; ai < 2; ++ai)
#pragma unroll
            for (int m = 0; m < 4; ++m) { bf16_t* rowp = O + (size_t)(row0 + ai * HALF + m * 16) * ldc + col0;
#pragma unroll
                for (int bj = 0; bj < 2; ++bj) *(u32x4*)(rowp + bj * HALF) = pack8(acc[ai][bj][m][0], acc[ai][bj][m][1]); }
    }
};
struct EpiKV {
    static constexpr bool PERM = true, AFTER_DRAIN = false;
    bf16_t* KN; bf16_t* VN;
    __device__ __forceinline__ void operator()(const f32x4 (&acc)[2][2][4][2], const Unit& u, int wr, int wc, int fr, int fq) const {
        const int row0 = u.pm * BM + wr * 64 + fr, d0 = wc * 32 + 8 * fq, head = u.pn;
#pragma unroll
        for (int ai = 0; ai < 2; ++ai)
#pragma unroll
            for (int m = 0; m < 4; ++m) { const size_t off = (size_t)(row0 + ai * HALF + m * 16) * 2048 + head * 128 + d0;
                *(u32x4*)(KN + off) = pack8(acc[ai][0][m][0], acc[ai][0][m][1]);
                *(u32x4*)(VN + off) = pack8(acc[ai][1][m][0], acc[ai][1][m][1]); }
    }
};
struct EpiQ {
    static constexpr bool PERM = true, AFTER_DRAIN = false;
    bf16_t* Q; const float* COS; const float* SIN; float qscale;
    __device__ __forceinline__ void operator()(const f32x4 (&acc)[2][2][4][2], const Unit& u, int wr, int wc, int fr, int fq) const {
        const int row0 = u.pm * BM + wr * 64 + fr;
        if (u.pn < 8) {
#pragma unroll
            for (int ai = 0; ai < 2; ++ai)
#pragma unroll
                for (int m = 0; m < 4; ++m) { const int row = row0 + ai * HALF + m * 16;
#pragma unroll
                    for (int bj = 0; bj < 2; ++bj) *(u32x4*)(Q + (size_t)row * 3072 + (2 * u.pn + bj) * 192 + wc * 32 + 8 * fq) = pack8(acc[ai][bj][m][0] * qscale, acc[ai][bj][m][1] * qscale); }
        } else {
            const int head = 4 * (u.pn - 8) + wc;
#pragma unroll
            for (int ai = 0; ai < 2; ++ai)
#pragma unroll
                for (int m = 0; m < 4; ++m) { const int row = row0 + ai * HALF + m * 16;
                    const f32x4 c0 = *(const f32x4*)(COS + (size_t)row * 32 + 8 * fq), c1 = *(const f32x4*)(COS + (size_t)row * 32 + 8 * fq + 4);
                    const f32x4 s0 = *(const f32x4*)(SIN + (size_t)row * 32 + 8 * fq), s1 = *(const f32x4*)(SIN + (size_t)row * 32 + 8 * fq + 4);
                    const f32x4 a0 = acc[ai][0][m][0] * qscale, a1 = acc[ai][0][m][1] * qscale, b0 = acc[ai][1][m][0] * qscale, b1 = acc[ai][1][m][1] * qscale;
                    const f32x4 o10 = a0 * c0 - b0 * s0, o11 = a1 * c1 - b1 * s1, o20 = a0 * s0 + b0 * c0, o21 = a1 * s1 + b1 * c1;
                    bf16_t* qp = Q + (size_t)row * 3072 + head * 192 + 128 + 8 * fq;
                    *(u32x4*)(qp) = pack8(o10, o11); *(u32x4*)(qp + 32) = pack8(o20, o21); }
        }
    }
};
struct EpiH {
    static constexpr bool PERM = true, AFTER_DRAIN = false;
    bf16_t* HQ; bf16_t* LOGF; bf16_t* HI; const float* LB;
    __device__ __forceinline__ void operator()(const f32x4 (&acc)[2][2][4][2], const Unit& u, int wr, int wc, int fr, int fq) const {
        const int row0 = u.pm * BM + wr * 64 + fr; const int seg = u.pn >> 3, col0 = (u.pn & 7) * BM + wc * 32 + 8 * fq;
        if (seg == 1) {
#pragma unroll
            for (int bj = 0; bj < 2; ++bj) { const f32x4 l0 = *(const f32x4*)(LB + col0 + bj * HALF), l1 = *(const f32x4*)(LB + col0 + bj * HALF + 4);
#pragma unroll
                for (int ai = 0; ai < 2; ++ai)
#pragma unroll
                    for (int m = 0; m < 4; ++m) { bf16_t* p = LOGF + (size_t)(row0 + ai * HALF + m * 16) * 2048 + col0 + bj * HALF; f32x4 v0, v1;
#pragma unroll
                        for (int e = 0; e < 4; ++e) { v0[e] = __logf(l0[e] + (1.0f - l0[e]) * fsigmoid(acc[ai][bj][m][0][e])); v1[e] = __logf(l1[e] + (1.0f - l1[e]) * fsigmoid(acc[ai][bj][m][1][e])); }
                        *(u32x4*)p = pack8(v0, v1); } }
        } else {
            bf16_t* O = seg == 0 ? HQ : HI;
#pragma unroll
            for (int ai = 0; ai < 2; ++ai)
#pragma unroll
                for (int m = 0; m < 4; ++m) { bf16_t* rowp = O + (size_t)(row0 + ai * HALF + m * 16) * 2048 + col0;
#pragma unroll
                    for (int bj = 0; bj < 2; ++bj) { f32x4 v0 = acc[ai][bj][m][0], v1 = acc[ai][bj][m][1];
                        if (seg == 0) {
#pragma unroll
                            for (int e = 0; e < 4; ++e) { v0[e] = fsilu(v0[e]); v1[e] = fsilu(v1[e]); } }
                        *(u32x4*)(rowp + bj * HALF) = pack8(v0, v1); } }
        }
    }
};
struct EpiHG {
    static constexpr bool PERM = true, AFTER_DRAIN = false;
    bf16_t* OB; const float* SSQ; const float* ONORM; float eps;
    __device__ __forceinline__ void operator()(const f32x4 (&acc)[2][2][4][2], const Unit& u, int wr, int wc, int fr, int fq) const {
        const int row0 = u.pm * BM + wr * 64 + fr, d0 = wc * 32 + 8 * fq;
        const f32x4 w0 = *(const f32x4*)(ONORM + d0), w1 = *(const f32x4*)(ONORM + d0 + 4);
#pragma unroll
        for (int ai = 0; ai < 2; ++ai) {
#pragma unroll
          for (int mp = 0; mp < 2; ++mp) {
            u32x4 ol[4][2]; f32x4 sq[4];
#pragma unroll
            for (int m = 2 * mp; m < 2 * mp + 2; ++m) { const int row = row0 + ai * HALF + m * 16; sq[m] = *(const f32x4*)(SSQ + (size_t)row * 32 + 4 * u.pn);
#pragma unroll
                for (int bj = 0; bj < 2; ++bj) ol[m][bj] = *(const u32x4*)(OB + (size_t)row * 2048 + u.pn * BM + bj * HALF + d0); }
#pragma unroll
            for (int m = 2 * mp; m < 2 * mp + 2; ++m) { const int row = row0 + ai * HALF + m * 16;
#pragma unroll
                for (int bj = 0; bj < 2; ++bj) { const float ss = bj == 0 ? sq[m][0] + sq[m][1] : sq[m][2] + sq[m][3]; const float rstd = __builtin_amdgcn_rsqf(ss * (1.0f / 128.0f) + eps);
                    bf16_t* p = OB + (size_t)row * 2048 + u.pn * BM + bj * HALF + d0; f32x4 o0, o1; unpack8(ol[m][bj], o0, o1);
#pragma unroll
                    for (int e = 0; e < 4; ++e) { o0[e] = o0[e] * rstd * w0[e] * fsilu(acc[ai][bj][m][0][e]); o1[e] = o1[e] * rstd * w1[e] * fsilu(acc[ai][bj][m][1][e]); }
                    *(u32x4*)p = pack8(o0, o1); } }
          }
        }
    }
};
struct EpiGate {
    static constexpr bool PERM = true, AFTER_DRAIN = false;
    bf16_t* GA; bf16_t* GB;
    __device__ __forceinline__ void operator()(const f32x4 (&acc)[2][2][4][2], const Unit& u, int wr, int wc, int fr, int fq) const {
        const int row0 = u.pm * BM + wr * 64 + fr, col0 = (u.pn & 7) * BM + wc * 32 + 8 * fq; bf16_t* O = (u.pn < 8) ? GA : GB;
#pragma unroll
        for (int ai = 0; ai < 2; ++ai)
#pragma unroll
            for (int m = 0; m < 4; ++m) { bf16_t* rowp = O + (size_t)(row0 + ai * HALF + m * 16) * 2048 + col0;
#pragma unroll
                for (int bj = 0; bj < 2; ++bj) { f32x4 v0, v1;
#pragma unroll
                    for (int e = 0; e < 4; ++e) { v0[e] = fsigmoid(acc[ai][bj][m][0][e]); v1[e] = fsigmoid(acc[ai][bj][m][1][e]); }
                    *(u32x4*)(rowp + bj * HALF) = pack8(v0, v1); } }
    }
};
template <int MODE> struct EpiMix {
    static constexpr bool PERM = true, AFTER_DRAIN = false;
    bf16_t* G; bf16_t* G2;
    __device__ __forceinline__ void operator()(const f32x4 (&acc)[2][2][4][2], const Unit& u, int wr, int wc, int fr, int fq) const {
        const int row0 = u.pm * BM + wr * 64 + fr, col0 = u.pn * BM + wc * 32 + 8 * fq;
#pragma unroll
        for (int ai = 0; ai < 2; ++ai) {
#pragma unroll
          for (int mp = 0; mp < 2; ++mp) {
            u32x4 gl[4][2], hl[4][2];
#pragma unroll
            for (int m = 2 * mp; m < 2 * mp + 2; ++m)
#pragma unroll
                for (int bj = 0; bj < 2; ++bj) { const size_t off = (size_t)(row0 + ai * HALF + m * 16) * 2048 + col0 + bj * HALF; gl[m][bj] = *(const u32x4*)(G + off); if (MODE == 1) hl[m][bj] = *(const u32x4*)(G2 + off); }
#pragma unroll
            for (int m = 2 * mp; m < 2 * mp + 2; ++m)
#pragma unroll
                for (int bj = 0; bj < 2; ++bj) { const size_t off = (size_t)(row0 + ai * HALF + m * 16) * 2048 + col0 + bj * HALF; f32x4 g0, g1; unpack8(gl[m][bj], g0, g1);
                    if (MODE == 0) { *(u32x4*)(G + off) = pack8(g0 * acc[ai][bj][m][0], g1 * acc[ai][bj][m][1]); }
                    else { f32x4 h0, h1; unpack8(hl[m][bj], h0, h1); *(u32x4*)(G2 + off) = pack8(g0 + h0 * acc[ai][bj][m][0], g1 + h1 * acc[ai][bj][m][1]); } }
          }
        }
    }
};
template <class Epi, class Sched, bool ALIGN_EPI = false, bool SP2 = false>
__device__ __forceinline__ void gemm_phase(PG8_LAS unsigned char* lds, const Gemm g, const Sched& S, const Epi& E) {
    int tid = threadIdx.x; asm volatile("" : "+v"(tid));
    const int wid = __builtin_amdgcn_readfirstlane(tid >> 6), lane = tid & 63, wr = wid >> 2, wc = wid & 3, fr = lane & 15, fq = lane >> 4;
    const int K = g.K, nt = K / BK;
    unsigned voffA[2], voffB[2];
#pragma unroll
    for (int i = 0; i < 2; ++i) { int R, C; stage_rc(tid * 16 + i * 8192, R, C); const int Rb = Epi::PERM ? ((R & ~31) + perm32(R & 31)) : R;
        voffA[i] = (unsigned)(R * K + C) * 2u; voffB[i] = (unsigned)(Rb * K + C) * 2u; }
    const size_t kstep = (size_t)(BK * 2);
    const size_t hstep = (size_t)HALF * K * 2;
    const size_t tstep = 2 * hstep;
    const unsigned ldsw = (unsigned)wid * 1024u;
    const int aoff = lds_byte(wr * 64 + fr, fq * 8), boff = lds_byte(wc * 32 + fr, fq * 8);
#define PG8_SA(b, h) (((b) * 2 + (h)) * HTB)
#define PG8_SB(b, h) ((4 + (b) * 2 + (h)) * HTB)
#define PG8_STAGE(bufoff, gbase, voff) do { _Pragma("unroll") for (int _i = 0; _i < 2; ++_i) \
        __builtin_amdgcn_global_load_lds((const unsigned*)((const char*)(gbase) + (voff)[_i]), (PG8_LAS unsigned*)(lds + (bufoff) + ldsw + _i * 8192), 16, 0, 0); } while (0)
#define PG8_LDA(dst, b, h) do { _Pragma("unroll") for (int m = 0; m < 4; ++m) _Pragma("unroll") for (int k = 0; k < 2; ++k) dst[m][k] = *(const PG8_LAS bf16x8*)(lds + PG8_SA(b, h) + aoff + m * 2048 + k * 1024); } while (0)
#define PG8_LDB(dst, b, h) do { _Pragma("unroll") for (int n = 0; n < 2; ++n) _Pragma("unroll") for (int k = 0; k < 2; ++k) dst[n][k] = *(const PG8_LAS bf16x8*)(lds + PG8_SB(b, h) + boff + n * 2048 + k * 1024); } while (0)
#define PG8_MMA(ai, bj, At, Bt) do { __builtin_amdgcn_s_setprio(1); _Pragma("unroll") for (int m = 0; m < 4; ++m) _Pragma("unroll") for (int n = 0; n < 2; ++n) _Pragma("unroll") for (int k = 0; k < 2; ++k) \
        acc[ai][bj][m][n] = __builtin_amdgcn_mfma_f32_16x16x32_bf16(Bt[n][k], At[m][k], acc[ai][bj][m][n], 0, 0, 0); __builtin_amdgcn_s_setprio(0); } while (0)
#define PG8_WAIT_V(n) asm volatile("s_waitcnt vmcnt(" #n ")" ::: "memory")
#define PG8_WAIT_L(n) asm volatile("s_waitcnt lgkmcnt(" #n ")" ::: "memory")
#define PG8_BAR __builtin_amdgcn_s_barrier()
#define PG8_SCHED __builtin_amdgcn_sched_barrier(0)
    Unit cur, nxt; int ui = 0;
    if (!S.next(0, cur)) return;
    f32x4 acc[2][2][4][2];
#pragma unroll
    for (int a = 0; a < 2; ++a)
#pragma unroll
        for (int b = 0; b < 2; ++b)
#pragma unroll
            for (int m = 0; m < 4; ++m)
#pragma unroll
                for (int n = 0; n < 2; ++n) acc[a][b][m][n] = (f32x4){0.f, 0.f, 0.f, 0.f};
    bf16x8 At[4][2], B0[2][2], B1[2][2];
    const char* cA = (const char*)g.A + (size_t)cur.pm * tstep; const char* cB = (const char*)g.Bt + (size_t)cur.pn * tstep;
    S.a_ready(cur);
    if constexpr (SP2) {
        PG8_STAGE(PG8_SB(0, 0), cB, voffB); PG8_STAGE(PG8_SB(0, 1), cB + hstep, voffB); PG8_STAGE(PG8_SA(0, 0), cA, voffA); PG8_STAGE(PG8_SA(0, 1), cA + hstep, voffA);
        if (wr == 1) PG8_BAR;
        PG8_WAIT_V(2); PG8_BAR;
        PG8_STAGE(PG8_SB(1, 0), cB + kstep, voffB); PG8_STAGE(PG8_SA(1, 0), cA + kstep, voffA); PG8_STAGE(PG8_SB(1, 1), cB + hstep + kstep, voffB);
        PG8_WAIT_V(6); PG8_BAR;
    } else {
        PG8_STAGE(PG8_SB(0, 0), cB, voffB); PG8_STAGE(PG8_SA(0, 0), cA, voffA); PG8_STAGE(PG8_SB(0, 1), cB + hstep, voffB); PG8_STAGE(PG8_SA(0, 1), cA + hstep, voffA);
        if (wr == 1) PG8_BAR;
        PG8_WAIT_V(4); PG8_BAR;
        PG8_STAGE(PG8_SB(1, 0), cB + kstep, voffB); PG8_STAGE(PG8_SA(1, 0), cA + kstep, voffA); PG8_STAGE(PG8_SB(1, 1), cB + hstep + kstep, voffB);
        PG8_WAIT_V(6); PG8_BAR;
    }
    for (;;) {
        const bool has_next = S.next(ui + 1, nxt);
        const char* nA = has_next ? (const char*)g.A + (size_t)nxt.pm * tstep : cA; const char* nB = has_next ? (const char*)g.Bt + (size_t)nxt.pn * tstep : cB;
        for (int t = 0; t < nt; t += 2) {
            const bool last = (t == nt - 2);
            const char* a1 = cA + (size_t)(t + 1) * kstep;
            const char* a2 = last ? nA : cA + (size_t)(t + 2) * kstep; const char* b2 = last ? nB : cB + (size_t)(t + 2) * kstep;
            const char* a3 = a2 + kstep; const char* b3 = b2 + kstep;
            if (last && has_next) S.a_ready(nxt);
            if constexpr (SP2) {
            PG8_LDB(B0, 0, 0); PG8_LDB(B1, 0, 1); PG8_SCHED; PG8_LDA(At, 0, 0); PG8_STAGE(PG8_SA(1, 1), a1 + hstep, voffA);
            PG8_WAIT_V(8); PG8_WAIT_L(0); PG8_BAR; PG8_MMA(0, 0, At, B0); PG8_MMA(0, 1, At, B1); PG8_BAR; PG8_SCHED;
            PG8_LDA(At, 0, 1); PG8_STAGE(PG8_SB(0, 0), b2, voffB); PG8_STAGE(PG8_SB(0, 1), b2 + hstep, voffB); PG8_STAGE(PG8_SA(0, 0), a2, voffA);
            PG8_WAIT_V(8); PG8_WAIT_L(0); PG8_BAR; PG8_MMA(1, 0, At, B0); PG8_MMA(1, 1, At, B1); PG8_BAR; PG8_SCHED;
            PG8_LDB(B0, 1, 0); PG8_LDB(B1, 1, 1); PG8_SCHED; PG8_LDA(At, 1, 0); PG8_STAGE(PG8_SA(0, 1), a2 + hstep, voffA);
            PG8_WAIT_V(8); PG8_WAIT_L(0); PG8_BAR; PG8_MMA(0, 0, At, B0); PG8_MMA(0, 1, At, B1); PG8_BAR; PG8_SCHED;
            PG8_LDA(At, 1, 1); PG8_STAGE(PG8_SB(1, 0), b3, voffB); PG8_STAGE(PG8_SB(1, 1), b3 + hstep, voffB); PG8_STAGE(PG8_SA(1, 0), a3, voffA);
            PG8_WAIT_V(8); PG8_WAIT_L(0); PG8_BAR; PG8_MMA(1, 0, At, B0); PG8_MMA(1, 1, At, B1); PG8_BAR; PG8_SCHED;
            } else {
            PG8_LDB(B0, 0, 0); PG8_SCHED; PG8_LDA(At, 0, 0); PG8_STAGE(PG8_SA(1, 1), a1 + hstep, voffA);
            PG8_WAIT_L(8); PG8_BAR; PG8_WAIT_L(0); PG8_MMA(0, 0, At, B0); PG8_BAR; PG8_SCHED;
            PG8_LDB(B1, 0, 1); PG8_STAGE(PG8_SB(0, 0), b2, voffB);
            PG8_BAR; PG8_WAIT_L(0); PG8_MMA(0, 1, At, B1); PG8_BAR;
            PG8_LDA(At, 0, 1); PG8_STAGE(PG8_SA(0, 0), a2, voffA);
            PG8_BAR; PG8_WAIT_L(0); PG8_MMA(1, 0, At, B0); PG8_BAR; PG8_SCHED;
            PG8_STAGE(PG8_SB(0, 1), b2 + hstep, voffB);
            PG8_WAIT_V(6); PG8_BAR; PG8_MMA(1, 1, At, B1); PG8_BAR;
            PG8_LDB(B0, 1, 0); PG8_SCHED; PG8_LDA(At, 1, 0); PG8_STAGE(PG8_SA(0, 1), a2 + hstep, voffA);
            PG8_WAIT_L(8); PG8_BAR; PG8_WAIT_L(0); PG8_MMA(0, 0, At, B0); PG8_BAR; PG8_SCHED;
            PG8_LDB(B1, 1, 1); PG8_STAGE(PG8_SB(1, 0), b3, voffB);
            PG8_BAR; PG8_WAIT_L(0); PG8_MMA(0, 1, At, B1); PG8_BAR;
            PG8_LDA(At, 1, 1); PG8_STAGE(PG8_SA(1, 0), a3, voffA);
            PG8_BAR; PG8_WAIT_L(0); PG8_MMA(1, 0, At, B0); PG8_BAR; PG8_SCHED;
            PG8_STAGE(PG8_SB(1, 1), b3 + hstep, voffB);
            PG8_WAIT_V(6); PG8_BAR; PG8_MMA(1, 1, At, B1); PG8_BAR;
            }
        }
        if constexpr (ALIGN_EPI) { if (wr == 0) PG8_BAR; }
        if constexpr (!Epi::AFTER_DRAIN) { E(acc, cur, wr, wc, fr, fq); S.done(cur); }
        if (!has_next) break;
#pragma unroll
        for (int a = 0; a < 2; ++a)
#pragma unroll
            for (int b = 0; b < 2; ++b)
#pragma unroll
                for (int m = 0; m < 4; ++m)
#pragma unroll
                    for (int n = 0; n < 2; ++n) acc[a][b][m][n] = (f32x4){0.f, 0.f, 0.f, 0.f};
        cur = nxt; cA = nA; cB = nB; ++ui;
        if constexpr (ALIGN_EPI) { if (wr == 1) PG8_BAR; }
    }
    PG8_WAIT_V(0);
    if constexpr (!ALIGN_EPI) { if (wr == 0) PG8_BAR; }
    PG8_BAR;
    if constexpr (Epi::AFTER_DRAIN) { E.fused(acc, cur, wr, wc, fr, fq, lds, wid, lane); S.done(cur); }
#undef PG8_SA
#undef PG8_SB
#undef PG8_STAGE
#undef PG8_LDA
#undef PG8_LDB
#undef PG8_MMA
#undef PG8_WAIT_V
#undef PG8_WAIT_L
#undef PG8_BAR
#undef PG8_SCHED
}
}
constexpr int NWAVES = 8, NTHR = 512;
constexpr int T = 16384, D = 2048, FF = 5632, SEQ = 2048, NB = 8, NH = 16;
constexpr float EPS = 1e-6f;
constexpr size_t MiB = 1u << 20, U = 64 * MiB;
constexpr size_t WS_SMALL = 1 * MiB;
constexpr size_t SM_LB = 0, SM_COS = 1 * MiB, SM_SIN = 3 * MiB, SM_KR = 5 * MiB, SM_SSQ = 7 * MiB;
constexpr size_t WS_WFFGU = 11 * MiB;
constexpr size_t WS_WFFD = WS_WFFGU + 44 * MiB;
constexpr size_t WS_WIN = WS_WFFD + 22 * MiB;
constexpr size_t WS_WQ = WS_WIN + 53 * MiB;
constexpr size_t WS_WKV = WS_WQ + 3 * MiB;
constexpr size_t WS_WMO = WS_WKV + 4 * MiB, WS_WHO = WS_WMO + 8 * MiB, WS_WOUT = WS_WHO + 8 * MiB;
constexpr size_t WS_ACT = WS_WOUT + 8 * MiB;
constexpr size_t WS_END = WS_ACT + 6 * U;
constexpr size_t A_HN = 0;
constexpr size_t A_ACT1 = 1 * U;
constexpr size_t A_Y1 = 3 * U + 3 * U / 4;
constexpr size_t A_CQKV = 1 * U, A_OA = 1 * U;
constexpr size_t A_Q = 2 * U, A_KN = 3 * U + U / 2, A_VT = 4 * U + U / 2;
constexpr size_t A_CQN = 5 * U + U / 2, A_CKVN = 5 * U + U / 2 + 16 * MiB;
constexpr size_t A_HQ = 2 * U, A_LOGF = 3 * U, A_HI = 5 * U;
constexpr size_t A_GA = 2 * U, A_GB = 3 * U;
constexpr size_t A_Y2 = 0;
constexpr size_t A_HN3 = 4 * U;
constexpr size_t A_ACT2 = 0;
constexpr size_t A_Y3 = 3 * U;

constexpr int LDS_BYTES = 147456;

#define GAS __attribute__((address_space(1)))
#define LAS __attribute__((address_space(3)))
typedef unsigned short bf16;
typedef unsigned v4u __attribute__((ext_vector_type(4)));
typedef unsigned v2u __attribute__((ext_vector_type(2)));
typedef float f32x4 __attribute__((ext_vector_type(4)));
typedef float f32x16 __attribute__((ext_vector_type(16)));
typedef short bf16x8 __attribute__((ext_vector_type(8)));
typedef short s16x4 __attribute__((ext_vector_type(4)));
typedef short v4i16_t __attribute__((ext_vector_type(4)));
typedef float f32x2_t __attribute__((ext_vector_type(2)));
typedef __bf16 bf16x2_t __attribute__((ext_vector_type(2)));
#define LDS_WAIT() asm volatile("s_waitcnt lgkmcnt(0)" ::: "memory")
#define MFMA32(a, b, c) __builtin_amdgcn_mfma_f32_32x32x16_bf16((a), (b), (c), 0, 0, 0)
__device__ __forceinline__ unsigned f2bf(float f) { unsigned u = __builtin_bit_cast(unsigned, f); return (u + 0x7fffu + ((u >> 16) & 1u)) >> 16; }
__device__ __forceinline__ unsigned pk2(float lo, float hi) { f32x2_t v = {lo, hi}; bf16x2_t b = __builtin_convertvector(v, bf16x2_t); return __builtin_bit_cast(unsigned, b); }
__device__ __forceinline__ float bflo(unsigned u) { return __uint_as_float(u << 16); }
__device__ __forceinline__ float bfhi(unsigned u) { return __uint_as_float(u & 0xffff0000u); }
__device__ __forceinline__ float bf2f(bf16 b) { return __uint_as_float(((unsigned)b) << 16); }
__device__ __forceinline__ float wave_sum(float v) {
#pragma unroll
    for (int o = 1; o < 64; o <<= 1) v += __shfl_xor(v, o);
    return v;
}
__device__ __forceinline__ float fsig(float x) { return __builtin_amdgcn_rcpf(1.0f + __expf(-x)); }

struct Ctx { LAS unsigned char* lds; int tid, lane, wave, G, bid; };

__device__ __forceinline__ void conv_item(const float* W, int K, int N, int scol0, bf16* WT, int drow0, int k0, LAS float* scr, int lane) {
    float wv[32];
    { const float* src = W + (size_t)(k0 + (lane >> 5)) * N + scol0 + (lane & 31);
#pragma unroll
      for (int i = 0; i < 32; ++i) wv[i] = src[(size_t)(2 * i) * N]; }
#pragma unroll
    for (int i = 0; i < 32; ++i) scr[(2 * i + (lane >> 5)) * 33 + (lane & 31)] = wv[i];
    LDS_WAIT(); asm volatile("" ::: "memory");
    const int c = lane & 7;
#pragma unroll
    for (int j = 0; j < 4; ++j) { const int n = (lane >> 3) + 8 * j; const LAS float* s = scr + (8 * c) * 33 + n;
        v4u o; o.x = pk2(s[0 * 33], s[1 * 33]); o.y = pk2(s[2 * 33], s[3 * 33]); o.z = pk2(s[4 * 33], s[5 * 33]); o.w = pk2(s[6 * 33], s[7 * 33]);
        *(GAS v4u*)(WT + (size_t)(drow0 + n) * K + k0 + 8 * c) = o; }
    LDS_WAIT(); asm volatile("" ::: "memory");
}
__device__ __forceinline__ void zero_item(bf16* WT, int K, int drow0, int k0, int lane) {
    const int c = lane & 7;
#pragma unroll
    for (int j = 0; j < 4; ++j) { const int n = (lane >> 3) + 8 * j; *(GAS v4u*)(WT + (size_t)(drow0 + n) * K + k0 + 8 * c) = (v4u){0u, 0u, 0u, 0u}; }
}
__device__ __forceinline__ void conv_ffn(const Ctx& C, const float* wg, const float* wu, const float* wd, bf16* WGU, bf16* WD, int b0 = 0) {
    LAS float* scr = (LAS float*)(C.lds + C.wave * 16384);
    const int gw = (C.bid - b0) * NWAVES + C.wave, NGW = (C.G - b0) * NWAVES;
    if (C.bid < b0) return;
    constexpr int KB1 = D / 64, I_GU = (11264 / 32) * KB1, KB2 = FF / 64, I_D = (D / 32) * KB2;
    for (int it = gw; it < I_GU + I_D; it += NGW) {
        if (it < I_GU) { const int g = it / KB1, kb = it % KB1; const int tile = g >> 3, w = (g & 7) * 32;
            const float* src = (w < 128) ? wg : wu; const int scol = tile * 128 + (w & 127);
            conv_item(src, D, FF, scol, WGU, 32 * g, 64 * kb, scr, C.lane); }
        else { const int r = it - I_GU; const int g = r / KB2, kb = r % KB2; conv_item(wd, FF, D, 32 * g, WD, 32 * g, 64 * kb, scr, C.lane); }
    }
}
__device__ __forceinline__ void conv_mixer(const Ctx& C, const float* w_in, const float* wq, const float* wkv, const float* wmo, const float* who, const float* wout,
                                           bf16* WIN, bf16* WQ, bf16* WKV, bf16* WMO, bf16* WHO, bf16* WOUT) {
    LAS float* scr = (LAS float*)(C.lds + C.wave * 16384);
    const int gw = C.bid * NWAVES + C.wave, NGW = C.G * NWAVES;
    constexpr int KB = D / 64  , KBL = 512 / 64  ;
    constexpr int I_IN = (13568 / 32) * KB, I_Q = (3072 / 32) * KBL, I_KV = (4096 / 32) * KBL, I_SQ = (2048 / 32) * KB;
    for (int it = gw; it < I_IN + I_Q + I_KV + 3 * I_SQ; it += NGW) {
        int r = it;
        if (r < I_IN) { const int g = r / KB, kb = r % KB; const int drow = 32 * g;
            if (drow < 12288) conv_item(w_in, D, 13376, 1088 + drow, WIN, drow, 64 * kb, scr, C.lane);
            else if (drow < 12288 + 1088) conv_item(w_in, D, 13376, drow - 12288, WIN, drow, 64 * kb, scr, C.lane);
            else zero_item(WIN, D, drow, 64 * kb, C.lane);
            continue; }
        r -= I_IN;
        if (r < I_Q) { const int g = r / KBL, kb = r % KBL; const int drow = 32 * g, pn = drow >> 8, w = drow & 255; int scol;
            if (pn < 8) scol = (2 * pn + (w >> 7)) * 192 + (w & 127);
            else { const int head = 4 * (pn - 8) + ((w & 127) >> 5); scol = head * 192 + 128 + ((w >> 7) ? 32 : 0); }
            conv_item(wq, 512, 3072, scol, WQ, drow, 64 * kb, scr, C.lane); continue; }
        r -= I_Q;
        if (r < I_KV) { const int g = r / KBL, kb = r % KBL; conv_item(wkv, 512, 4096, 32 * g, WKV, 32 * g, 64 * kb, scr, C.lane); continue; }
        r -= I_KV;
        { const int which = r / I_SQ; r -= which * I_SQ; const int g = r / KB, kb = r % KB;
          const float* src = which == 0 ? wmo : (which == 1 ? who : wout); bf16* dst = which == 0 ? WMO : (which == 1 ? WHO : WOUT);
          conv_item(src, D, D, 32 * g, dst, 32 * g, 64 * kb, scr, C.lane); }
    }
}

__device__ __forceinline__ void rows_norm(const Ctx& C, const float* x, const float* w, bf16* HN) {
    const int gw = C.bid * NWAVES + C.wave, NGW = C.G * NWAVES;
    for (int m = gw; m < T; m += NGW) {
        const GAS f32x4* xr = (const GAS f32x4*)(x + (size_t)m * D) + C.lane; f32x4 v[8]; float s = 0.f;
#pragma unroll
        for (int j = 0; j < 8; ++j) { v[j] = xr[64 * j]; s += (v[j].x * v[j].x + v[j].y * v[j].y) + (v[j].z * v[j].z + v[j].w * v[j].w); }
        const float rstd = 1.0f / sqrtf(wave_sum(s) * (1.0f / D) + EPS);
        GAS v2u* o = (GAS v2u*)(HN + (size_t)m * D) + C.lane;
#pragma unroll
        for (int j = 0; j < 8; ++j) { const f32x4 ww = *((const GAS f32x4*)w + C.lane + 64 * j); o[64 * j] = (v2u){pk2(v[j].x * rstd * ww.x, v[j].y * rstd * ww.y), pk2(v[j].z * rstd * ww.z, v[j].w * rstd * ww.w)}; }
    }
}
__device__ __forceinline__ void rows_update(const Ctx& C, const float* xin, const bf16* Y, const float* wpost, float scale, float* xout, const float* wpre, bf16* HN) {
    const int gw = C.bid * NWAVES + C.wave, NGW = C.G * NWAVES;
    for (int m = gw; m < T; m += NGW) {
        const GAS v2u* yr = (const GAS v2u*)(Y + (size_t)m * D) + C.lane; const GAS f32x4* xr = (const GAS f32x4*)(xin + (size_t)m * D) + C.lane;
        f32x4 v[8]; float s = 0.f;
#pragma unroll
        for (int j = 0; j < 8; ++j) { const v2u w = yr[64 * j]; v[j] = (f32x4){bflo(w.x), bfhi(w.x), bflo(w.y), bfhi(w.y)}; s += (v[j].x * v[j].x + v[j].y * v[j].y) + (v[j].z * v[j].z + v[j].w * v[j].w); }
        const float rstd = scale / sqrtf(wave_sum(s) * (1.0f / D) + EPS);
        GAS f32x4* xo = (GAS f32x4*)(xout + (size_t)m * D) + C.lane; float s2 = 0.f;
#pragma unroll
        for (int j = 0; j < 8; ++j) { const f32x4 ww = *((const GAS f32x4*)wpost + C.lane + 64 * j); const f32x4 xv = xr[64 * j];
            v[j] = xv + v[j] * rstd * ww; xo[64 * j] = v[j]; s2 += (v[j].x * v[j].x + v[j].y * v[j].y) + (v[j].z * v[j].z + v[j].w * v[j].w); }
        if (wpre) { const float r2 = 1.0f / sqrtf(wave_sum(s2) * (1.0f / D) + EPS);
            GAS v2u* o = (GAS v2u*)(HN + (size_t)m * D) + C.lane;
#pragma unroll
            for (int j = 0; j < 8; ++j) { const f32x4 ww = *((const GAS f32x4*)wpre + C.lane + 64 * j); o[64 * j] = (v2u){pk2(v[j].x * r2 * ww.x, v[j].y * r2 * ww.y), pk2(v[j].z * r2 * ww.z, v[j].w * r2 * ww.w)}; } }
    }
}
__device__ __forceinline__ void rows_latent(const Ctx& C, const bf16* CQKV, const float* qn, const float* kvn, const int* pos, bf16* CQN, bf16* CKVN, bf16* KR, float* COSt, float* SINt) {
    const int gw = C.bid * NWAVES + C.wave, NGW = C.G * NWAVES;
    const float invf = __builtin_amdgcn_exp2f(-(float)(C.lane & 31) * (13.287712379549449f / 32.0f));
    for (int m = gw; m < T; m += NGW) {
        const bf16* rowp = CQKV + (size_t)m * 1280;
#pragma unroll
        for (int part = 0; part < 2; ++part) {
            const GAS v4u* p = (const GAS v4u*)(rowp + part * 512) + C.lane; const v4u w = *p;
            float f[8] = {bflo(w.x), bfhi(w.x), bflo(w.y), bfhi(w.y), bflo(w.z), bfhi(w.z), bflo(w.w), bfhi(w.w)}; float s = 0.f;
#pragma unroll
            for (int e = 0; e < 8; ++e) s += f[e] * f[e];
            const float rstd = 1.0f / sqrtf(wave_sum(s) * (1.0f / 512.0f) + EPS);
            const float* nw = (part == 0 ? qn : kvn) + 8 * C.lane; const f32x4 n0 = *(const GAS f32x4*)nw, n1 = *(const GAS f32x4*)(nw + 4);
            v4u o; o.x = pk2(f[0] * rstd * n0.x, f[1] * rstd * n0.y); o.y = pk2(f[2] * rstd * n0.z, f[3] * rstd * n0.w); o.z = pk2(f[4] * rstd * n1.x, f[5] * rstd * n1.y); o.w = pk2(f[6] * rstd * n1.z, f[7] * rstd * n1.w);
            *((GAS v4u*)((part == 0 ? CQN : CKVN) + (size_t)m * 512) + C.lane) = o;
        }
        if (C.lane < 32) {
            const float ang = (float)pos[m] * invf;
            const double turns = (double)ang * 0.15915494309189535; const float fr = (float)(turns - __builtin_rint(turns));
            const float cs = __builtin_amdgcn_cosf(fr), sn = __builtin_amdgcn_sinf(fr);
            const float a = bf2f(rowp[1024 + C.lane]), b = bf2f(rowp[1056 + C.lane]);
            KR[(size_t)m * 64 + C.lane] = (bf16)f2bf(a * cs - b * sn); KR[(size_t)m * 64 + 32 + C.lane] = (bf16)f2bf(a * sn + b * cs);
            COSt[(size_t)m * 32 + C.lane] = cs; SINt[(size_t)m * 32 + C.lane] = sn;
        }
    }
}

namespace att {
constexpr int KP = 200, VP = 160;
constexpr int KT_B = 64 * KP * 2, VT_B = 64 * VP * 2, BUF_B = KT_B + VT_B;
static_assert(2 * BUF_B <= 131072, "attention LDS");
__device__ __forceinline__ void attn_unit(const Ctx& C, int b, int h, int qb, const bf16* Q, const bf16* KN, const bf16* KR, const bf16* VT, bf16* OA) {
    int tid = threadIdx.x; asm volatile("" : "+v"(tid));
    const int lane = tid & 63, r = lane & 31, hh = lane >> 5, w = __builtin_amdgcn_readfirstlane(tid >> 6);
    const int qrow0 = qb * 256 + 32 * w;
    const size_t tok0 = (size_t)b * SEQ;
    bf16x8 qf[12];
    { const bf16* qp = Q + (tok0 + qrow0 + r) * 3072 + h * 192 + 8 * hh;
#pragma unroll
      for (int s = 0; s < 12; ++s) qf[s] = *(const GAS bf16x8*)(qp + 16 * s); }
    f32x16 o[4];
#pragma unroll
    for (int d = 0; d < 4; ++d)
#pragma unroll
        for (int i = 0; i < 16; ++i) o[d][i] = 0.f;
    float mrow = -1e30f, lrow = 0.f;
    const int nkt = (qb + 1) * 4;
    int kkey[3], kpart[3];
#pragma unroll
    for (int i = 0; i < 3; ++i) { const int p = tid + 512 * i; kkey[i] = p / 24; kpart[i] = p % 24; }
    const bf16* vsrc[2]; int vdst[2];
#pragma unroll
    for (int i = 0; i < 2; ++i) { const int p = tid + 512 * i, key = p >> 4, part = p & 15; vsrc[i] = VT + (tok0 + key) * 2048 + h * 128 + part * 8; vdst[i] = key * VP * 2 + part * 16; }
    const int vtr0 = (4 * hh + ((lane & 15) >> 2)) * (VP * 2) + (16 * ((lane >> 4) & 1) + 4 * (lane & 3)) * 2;
    v4u kreg[3], vreg[2];
#define ATT_LOAD(kt) do { const int k0_ = (kt) * 64; _Pragma("unroll") for (int i = 0; i < 3; ++i) { const size_t tk = tok0 + k0_ + kkey[i]; \
        kreg[i] = (kpart[i] < 16) ? *(const GAS v4u*)(KN + tk * 2048 + h * 128 + kpart[i] * 8) : *(const GAS v4u*)(KR + tk * 64 + (kpart[i] - 16) * 8); } \
        _Pragma("unroll") for (int i = 0; i < 2; ++i) vreg[i] = *(const GAS v4u*)(vsrc[i] + (size_t)k0_ * 2048); } while (0)
#define ATT_STORE(buf) do { LAS unsigned char* kb_ = C.lds + (buf) * BUF_B; _Pragma("unroll") for (int i = 0; i < 3; ++i) *(LAS v4u*)(kb_ + kkey[i] * (KP * 2) + kpart[i] * 16) = kreg[i]; \
        _Pragma("unroll") for (int i = 0; i < 2; ++i) *(LAS v4u*)(kb_ + KT_B + vdst[i]) = vreg[i]; } while (0)
    ATT_LOAD(0); ATT_STORE(0);
    __syncthreads();
    for (int kt = 0; kt < nkt; ++kt) {
        const bool more = kt + 1 < nkt;
        if (more) ATT_LOAD(kt + 1);
        const int k0 = kt * 64;
        if (k0 <= qrow0 + 31) {
            const LAS unsigned char* kb = C.lds + (kt & 1) * BUF_B; const LAS unsigned char* vb = kb + KT_B;
            f32x16 s0, s1;
#pragma unroll
            for (int i = 0; i < 16; ++i) { s0[i] = 0.f; s1[i] = 0.f; }
#pragma unroll
            for (int s = 0; s < 12; ++s) {
                const bf16x8 a0 = *(const LAS bf16x8*)(kb + r * (KP * 2) + s * 32 + hh * 16);
                const bf16x8 a1 = *(const LAS bf16x8*)(kb + (32 + r) * (KP * 2) + s * 32 + hh * 16);
                s0 = MFMA32(a0, qf[s], s0); s1 = MFMA32(a1, qf[s], s1);
                if ((s & 1) == 1) __builtin_amdgcn_sched_barrier(0);
            }
            if (k0 + 63 > qrow0) {
                const int qpos = qrow0 + r;
#pragma unroll
                for (int i = 0; i < 16; ++i) { const int key = k0 + (i & 3) + 8 * (i >> 2) + 4 * hh; if (key > qpos) s0[i] = -1e30f; if (key + 32 > qpos) s1[i] = -1e30f; }
            }
            float mx = s0[0];
#pragma unroll
            for (int i = 1; i < 16; ++i) mx = fmaxf(mx, s0[i]);
#pragma unroll
            for (int i = 0; i < 16; ++i) mx = fmaxf(mx, s1[i]);
            mx = fmaxf(mx, __shfl_xor(mx, 32));
            const bool need = mx > mrow + 8.0f;
            if (__builtin_amdgcn_ballot_w64(need) != 0ull) {
                const float mnew = need ? mx : mrow, alpha = __builtin_amdgcn_exp2f(mrow - mnew);
                lrow *= alpha; mrow = mnew;
#pragma unroll
                for (int d = 0; d < 4; ++d)
#pragma unroll
                    for (int i = 0; i < 16; ++i) o[d][i] *= alpha;
            }
            float ps = 0.f;
#pragma unroll
            for (int i = 0; i < 16; ++i) { s0[i] = __builtin_amdgcn_exp2f(s0[i] - mrow); s1[i] = __builtin_amdgcn_exp2f(s1[i] - mrow); ps += s0[i] + s1[i]; }
            lrow += ps;
#pragma unroll
            for (int kt2 = 0; kt2 < 2; ++kt2)
#pragma unroll
                for (int sp = 0; sp < 2; ++sp) {
                    const f32x16& sv = kt2 == 0 ? s0 : s1;
                    v4u pw; pw.x = pk2(sv[8 * sp + 0], sv[8 * sp + 1]); pw.y = pk2(sv[8 * sp + 2], sv[8 * sp + 3]); pw.z = pk2(sv[8 * sp + 4], sv[8 * sp + 5]); pw.w = pk2(sv[8 * sp + 6], sv[8 * sp + 7]);
                    const bf16x8 pb = __builtin_bit_cast(bf16x8, pw);
#pragma unroll
                    for (int d = 0; d < 4; ++d) {
                        const LAS unsigned char* vp = vb + vtr0 + (kt2 * 32 + 16 * sp) * (VP * 2) + 64 * d;
                        const s16x4 lo = __builtin_bit_cast(s16x4, __builtin_amdgcn_ds_read_tr16_b64_v4i16((LAS v4i16_t*)vp)), hi = __builtin_bit_cast(s16x4, __builtin_amdgcn_ds_read_tr16_b64_v4i16((LAS v4i16_t*)(vp + 8 * VP * 2)));
                        const bf16x8 a = __builtin_shufflevector(lo, hi, 0, 1, 2, 3, 4, 5, 6, 7);
                        o[d] = MFMA32(a, pb, o[d]);
                    }
                    __builtin_amdgcn_sched_barrier(0);
                }
        }
        if (more) ATT_STORE((kt + 1) & 1);
        __syncthreads();
    }
#undef ATT_LOAD
#undef ATT_STORE
    const float ltot = lrow + __shfl_xor(lrow, 32), inv = 1.0f / ltot;
    bf16* op = OA + (tok0 + qrow0 + r) * 2048 + h * 128 + 4 * hh;
#pragma unroll
    for (int d = 0; d < 4; ++d)
#pragma unroll
        for (int g = 0; g < 4; ++g)
            *(GAS v2u*)(op + 32 * d + 8 * g) = (v2u){pk2(o[d][4 * g] * inv, o[d][4 * g + 1] * inv), pk2(o[d][4 * g + 2] * inv, o[d][4 * g + 3] * inv)};
}
__device__ __forceinline__ void attn_phase(const Ctx& C, const bf16* Q, const bf16* KN, const bf16* KR, const bf16* VT, bf16* OA) {
    for (int p = C.bid; p < 512; p += C.G) {
        const int bh = p >> 2, j = p & 3, b = bh >> 4, h = bh & 15;
        attn_unit(C, b, h, 7 - j, Q, KN, KR, VT, OA);
        attn_unit(C, b, h, j, Q, KN, KR, VT, OA);
    }
}
}

namespace hg {
constexpr int P128 = 136, P64 = 72, PL = 132;
constexpr int O_QD = 0, O_QT = O_QD + 64 * P128 * 2, O_KT = O_QT + 64 * P128 * 2, O_ST = O_KT + 64 * P128 * 2;
constexpr int O_KDT = O_ST + 64 * P128 * 2;
constexpr int O_VT = O_KDT + 128 * P64 * 2;
constexpr int O_SC = O_VT + 64 * P64 * 2;
constexpr int O_G = O_SC + 64 * P64 * 2;
constexpr int O_SEG = O_G + 512;
constexpr int O_OT = O_SEG + 4096;
constexpr int O_END = O_OT + 64 * P64 * 2;
constexpr int O_RQ = 0, O_RL = O_RQ + 64 * P128 * 2;
static_assert(O_RL + 64 * P128 * 2 <= O_ST && O_END <= 131072, "scan LDS");
__device__ __forceinline__ void scan_item(const Ctx& C, int b, int h, int half, const bf16* HQ, const bf16* LOGF, bf16* HI  , float* SSQ) {
    int tid = threadIdx.x; asm volatile("" : "+v"(tid));
    const int lane = tid & 63, r = lane & 31, hh = lane >> 5, w = __builtin_amdgcn_readfirstlane(tid >> 6);
    LAS unsigned char* L = C.lds;
    const size_t tokb = (size_t)b * SEQ;
    for (int i = tid; i < 64 * P128 / 2; i += NTHR) ((LAS unsigned*)(L + O_ST))[i] = 0u;
    f32x16 sacc;
#pragma unroll
    for (int i = 0; i < 16; ++i) sacc[i] = 0.f;
    const int kt_own = w >> 1, di_own = w & 1;
    const int vt_t = tid >> 3, vt_d = (tid & 7) * 8;
    v4u rq[2], rl[2], rv;
#define HG_LOAD(c) do { const size_t t0_ = tokb + (size_t)(c) * 64; \
        _Pragma("unroll") for (int i = 0; i < 2; ++i) { const int p_ = tid + 512 * i; rq[i] = *(const GAS v4u*)(HQ + (t0_ + (p_ >> 4)) * 2048 + h * 128 + (p_ & 15) * 8); } \
        _Pragma("unroll") for (int i = 0; i < 2; ++i) { const int p_ = tid + 512 * i; rl[i] = *(const GAS v4u*)(LOGF + (t0_ + (p_ >> 4)) * 2048 + h * 128 + (p_ & 15) * 8); } \
        rv = *(const GAS v4u*)(HI + (t0_ + vt_t) * 2048 + h * 128 + half * 64 + vt_d); } while (0)
#define HG_STORE_O(c) do { const v4u ov_ = *(const LAS v4u*)(L + O_OT + (vt_t * P64 + vt_d) * 2); \
        float sq_ = bflo(ov_.x) * bflo(ov_.x) + bfhi(ov_.x) * bfhi(ov_.x) + bflo(ov_.y) * bflo(ov_.y) + bfhi(ov_.y) * bfhi(ov_.y) + bflo(ov_.z) * bflo(ov_.z) + bfhi(ov_.z) * bfhi(ov_.z) + bflo(ov_.w) * bflo(ov_.w) + bfhi(ov_.w) * bfhi(ov_.w); \
        sq_ += __shfl_xor(sq_, 1); sq_ += __shfl_xor(sq_, 2); sq_ += __shfl_xor(sq_, 4); \
        const size_t tk_ = tokb + (size_t)(c) * 64 + vt_t; *(GAS v4u*)(HI + tk_ * 2048 + h * 128 + half * 64 + vt_d) = ov_; \
        if ((tid & 7) == 0) SSQ[tk_ * 32 + h * 2 + half] = sq_; } while (0)
    HG_LOAD(0);
    for (int c = 0; c < SEQ / 64; ++c) {
#pragma unroll
        for (int i = 0; i < 2; ++i) { const int p_ = tid + 512 * i; *(LAS v4u*)(L + O_RQ + ((p_ >> 4) * P128 + (p_ & 15) * 8) * 2) = rq[i]; }
#pragma unroll
        for (int i = 0; i < 2; ++i) { const int p_ = tid + 512 * i; *(LAS v4u*)(L + O_RL + ((p_ >> 4) * P128 + (p_ & 15) * 8) * 2) = rl[i]; }
        { const unsigned vw[4] = {rv.x, rv.y, rv.z, rv.w};
#pragma unroll
          for (int j = 0; j < 4; ++j) { *(LAS bf16*)(L + O_VT + ((vt_d + 2 * j) * P64 + vt_t) * 2) = (bf16)(vw[j] & 0xffffu); *(LAS bf16*)(L + O_VT + ((vt_d + 2 * j + 1) * P64 + vt_t) * 2) = (bf16)(vw[j] >> 16); } }
        if (c > 0) HG_STORE_O(c - 1);
        if (c + 1 < SEQ / 64) HG_LOAD(c + 1);
        __syncthreads();
        const int k0 = 2 * (tid & 63);
        float q0[8], q1[8], c0[8], c1[8], kk0[8], kk1[8];
        { float r0 = 0.f, r1 = 0.f;
#pragma unroll
          for (int i = 0; i < 8; ++i) { const int t = 8 * w + i; const unsigned lw = *(const LAS unsigned*)(L + O_RL + (t * P128 + k0) * 2); const unsigned qq = *(const LAS unsigned*)(L + O_RQ + (t * P128 + k0) * 2);
              const float l0 = bflo(lw) * 1.4426950408889634f, l1 = bfhi(lw) * 1.4426950408889634f; q0[i] = bflo(qq); q1[i] = bfhi(qq); r0 += l0; r1 += l1; c0[i] = r0; c1[i] = r1;
              kk0[i] = 1.0f - __builtin_amdgcn_exp2f(l0); kk1[i] = 1.0f - __builtin_amdgcn_exp2f(l1); }
          *(LAS f32x2_t*)(L + O_SEG + (w * 128 + k0) * 4) = (f32x2_t){r0, r1}; }
        __syncthreads();
        { float pre0 = 0.f, pre1 = 0.f, mid0 = 0.f, mid1 = 0.f, tot0 = 0.f, tot1 = 0.f;
#pragma unroll
          for (int s8 = 0; s8 < 8; ++s8) { const f32x2_t sv = *(const LAS f32x2_t*)(L + O_SEG + (s8 * 128 + k0) * 4); if (s8 < w) { pre0 += sv.x; pre1 += sv.y; } if (s8 < 4) { mid0 += sv.x; mid1 += sv.y; } tot0 += sv.x; tot1 += sv.y; }
          if (w == 0) *(LAS f32x2_t*)(L + O_G + k0 * 4) = (f32x2_t){__builtin_amdgcn_exp2f(tot0), __builtin_amdgcn_exp2f(tot1)};
          const float cm0 = __builtin_amdgcn_exp2f(fminf(-mid0, 115.f)), cm1 = __builtin_amdgcn_exp2f(fminf(-mid1, 115.f));
          float kd0[8], kd1[8];
#pragma unroll
          for (int i = 0; i < 8; ++i) { const int t = 8 * w + i; const float b0 = pre0 + c0[i], b1 = pre1 + c1[i];
              const float e0 = __builtin_amdgcn_exp2f(b0), e1 = __builtin_amdgcn_exp2f(b1);
              const float qd0 = q0[i] * e0, qd1 = q1[i] * e1, qt0 = qd0 * cm0, qt1 = qd1 * cm1;
              const float kt0 = kk0[i] * __builtin_amdgcn_exp2f(fminf(mid0 - b0, 115.f)), kt1 = kk1[i] * __builtin_amdgcn_exp2f(fminf(mid1 - b1, 115.f));
              kd0[i] = kk0[i] * __builtin_amdgcn_exp2f(tot0 - b0); kd1[i] = kk1[i] * __builtin_amdgcn_exp2f(tot1 - b1);
              *(LAS unsigned*)(L + O_QD + (t * P128 + k0) * 2) = pk2(qd0, qd1); *(LAS unsigned*)(L + O_QT + (t * P128 + k0) * 2) = pk2(qt0, qt1); *(LAS unsigned*)(L + O_KT + (t * P128 + k0) * 2) = pk2(kt0, kt1); }
          *(LAS v4u*)(L + O_KDT + (k0 * P64 + 8 * w) * 2) = (v4u){pk2(kd0[0], kd0[1]), pk2(kd0[2], kd0[3]), pk2(kd0[4], kd0[5]), pk2(kd0[6], kd0[7])};
          *(LAS v4u*)(L + O_KDT + ((k0 + 1) * P64 + 8 * w) * 2) = (v4u){pk2(kd1[0], kd1[1]), pk2(kd1[2], kd1[3]), pk2(kd1[4], kd1[5]), pk2(kd1[6], kd1[7])}; }
        __syncthreads();
        f32x16 acc;
#pragma unroll
        for (int i = 0; i < 16; ++i) acc[i] = 0.f;
        const int ti = (w & 3) >> 1, xi = w & 1;
        if (w < 4) {
            if (xi <= ti) {
#pragma unroll
                for (int s = 0; s < 8; ++s) { const bf16x8 a = *(const LAS bf16x8*)(L + O_QT + ((32 * ti + r) * P128 + 16 * s + 8 * hh) * 2), bb = *(const LAS bf16x8*)(L + O_KT + ((32 * xi + r) * P128 + 16 * s + 8 * hh) * 2); acc = MFMA32(a, bb, acc); }
            }
#pragma unroll
            for (int i = 0; i < 16; ++i) { const int t = 32 * ti + (i & 3) + 8 * (i >> 2) + 4 * hh, s = 32 * xi + r; const float v = (s <= t) ? acc[i] : 0.f; *(LAS bf16*)(L + O_SC + (t * P64 + s) * 2) = (bf16)f2bf(v); }
        } else {
#pragma unroll
            for (int s = 0; s < 8; ++s) { const bf16x8 a = *(const LAS bf16x8*)(L + O_QD + ((32 * ti + r) * P128 + 16 * s + 8 * hh) * 2), bb = *(const LAS bf16x8*)(L + O_ST + ((32 * xi + r) * P128 + 16 * s + 8 * hh) * 2); acc = MFMA32(a, bb, acc); }
        }
        __syncthreads();
        if (w >= 4) {
#pragma unroll
            for (int s = 0; s < 4; ++s) { const bf16x8 a = *(const LAS bf16x8*)(L + O_SC + ((32 * ti + r) * P64 + 16 * s + 8 * hh) * 2), bb = *(const LAS bf16x8*)(L + O_VT + ((32 * xi + r) * P64 + 16 * s + 8 * hh) * 2); acc = MFMA32(a, bb, acc); }
#pragma unroll
            for (int i = 0; i < 16; ++i) { const int t = 32 * ti + (i & 3) + 8 * (i >> 2) + 4 * hh; *(LAS bf16*)(L + O_OT + (t * P64 + 32 * xi + r) * 2) = (bf16)f2bf(acc[i]); }
        }
        { const LAS float* gp = (const LAS float*)(L + O_G) + 32 * kt_own + 4 * hh;
#pragma unroll
          for (int g = 0; g < 4; ++g) { const f32x4 gv = *(const LAS f32x4*)(gp + 8 * g);
#pragma unroll
              for (int e = 0; e < 4; ++e) sacc[4 * g + e] *= gv[e]; }
#pragma unroll
          for (int s = 0; s < 4; ++s) { const bf16x8 a = *(const LAS bf16x8*)(L + O_KDT + ((32 * kt_own + r) * P64 + 16 * s + 8 * hh) * 2), bb = *(const LAS bf16x8*)(L + O_VT + ((32 * di_own + r) * P64 + 16 * s + 8 * hh) * 2); sacc = MFMA32(a, bb, sacc); }
#pragma unroll
          for (int g = 0; g < 4; ++g) *(LAS v2u*)(L + O_ST + ((32 * di_own + r) * P128 + 32 * kt_own + 8 * g + 4 * hh) * 2) = (v2u){pk2(sacc[4 * g], sacc[4 * g + 1]), pk2(sacc[4 * g + 2], sacc[4 * g + 3])}; }
        __syncthreads();
    }
    HG_STORE_O(SEQ / 64 - 1);
#undef HG_LOAD
#undef HG_STORE_O
    __syncthreads();
}
__device__ __forceinline__ void scan_phase(const Ctx& C, const bf16* HQ, const bf16* LOGF, bf16* HI, float* SSQ) {
    for (int it = C.bid; it < NB * NH * 2; it += C.G) { const int half = it & 1, bh = it >> 1; scan_item(C, bh >> 4, bh & 15, half, HQ, LOGF, HI, SSQ); }
}
}
#define XB_TMO      128
#define XB_XCNT(j)  (256  + 64 * (j))
#define XB_XSUB(j)  (1280 + 64 * (j))
#define XB_XGEN(j)  (2304 + 64 * (j))
#define XB_TOP      3328
#define XB_TOPGEN   3392
#define XCD_BAR_WORDS 3456
#define XB_SPIN_CAP (1u << 18)

__device__ __forceinline__ unsigned xb_ld(unsigned* p)              { return __hip_atomic_load(p, __ATOMIC_RELAXED, __HIP_MEMORY_SCOPE_AGENT); }
__device__ __forceinline__ unsigned xb_add(unsigned* p, unsigned v) { return __hip_atomic_fetch_add(p, v, __ATOMIC_RELAXED, __HIP_MEMORY_SCOPE_AGENT); }
__device__ __forceinline__ unsigned xb_xcc_id() { return (unsigned)__builtin_amdgcn_s_getreg((3 << 11) | 20) & 0xFu; }
#define XB_SPIN(cond, bar) do { unsigned _sp = 0; while (cond) { __builtin_amdgcn_s_sleep(1); \
    if ((++_sp & 255u) == 0u) { if (xb_ld(&(bar)[XB_TMO])) break; if (_sp > XB_SPIN_CAP) { atomicAdd(&(bar)[XB_TMO], 1u); break; } } } } while (0)

struct XcdBarrier {
    unsigned* bar; unsigned x;
    volatile LAS unsigned* st;
};

__device__ __forceinline__ XcdBarrier xcd_barrier_post(unsigned* bar, volatile LAS unsigned* st) {
    XcdBarrier b; b.bar = bar; b.x = xb_xcc_id(); b.st = st;
    if (threadIdx.x == 0) (void)xb_add(&bar[XB_XCNT(b.x)], 1u);
    return b;
}
__device__ __forceinline__ void xcd_barrier_complete(unsigned* bar, unsigned x, unsigned& nloc, unsigned& nx) {
    const unsigned G = gridDim.x * gridDim.y * gridDim.z;
    unsigned sum, cnt, mine, sp = 0u;
    for (;;) {
        sum = 0u; cnt = 0u; mine = 0u;
#pragma unroll
        for (unsigned j = 0; j < 16; ++j) { const unsigned c = xb_ld(&bar[XB_XCNT(j)]); sum += c; cnt += (c > 0u) ? 1u : 0u; mine = (j == x) ? c : mine; }
        if (sum == G) break;
        __builtin_amdgcn_s_sleep(1);
        if ((++sp & 255u) == 0u) { if (xb_ld(&bar[XB_TMO])) break; if (sp > XB_SPIN_CAP) { atomicAdd(&bar[XB_TMO], 1u); break; } }
    }
    nloc = mine > 0u ? mine : 1u; nx = cnt > 0u ? cnt : 1u;
}

__device__ __forceinline__ void xcd_barrier(const XcdBarrier& b) {
    asm volatile("s_waitcnt vmcnt(0)" ::: "memory");
    __syncthreads();
    if (threadIdx.x == 0) {
        unsigned* bar = b.bar;
        __builtin_amdgcn_s_waitcnt(0);
        unsigned nloc = b.st[0], nx = b.st[1];
        if (nloc == 0u) { xcd_barrier_complete(bar, b.x, nloc, nx); b.st[0] = nloc; b.st[1] = nx; }
        const unsigned old = xb_add(&bar[XB_XSUB(b.x)], 1u);
        const unsigned gen = old / nloc;
        if (old + 1u == (gen + 1u) * nloc) {
            __builtin_amdgcn_fence(__ATOMIC_RELEASE, "agent");
            asm volatile("s_waitcnt vmcnt(0)" ::: "memory");
            const unsigned og = xb_add(&bar[XB_TOP], 1u);
            const unsigned tg = og / nx;
            if (og + 1u == (tg + 1u) * nx) xb_add(&bar[XB_TOPGEN], 1u);
            else XB_SPIN(xb_ld(&bar[XB_TOPGEN]) == tg, bar);
            __builtin_amdgcn_fence(__ATOMIC_ACQUIRE, "agent");
            xb_add(&bar[XB_XGEN(b.x)], 1u);
            asm volatile("s_waitcnt vmcnt(0)" ::: "memory");
        } else {
            XB_SPIN(xb_ld(&bar[XB_XGEN(b.x)]) == gen, bar);
            __builtin_amdgcn_fence(__ATOMIC_ACQUIRE, "agent");
            asm volatile("s_waitcnt vmcnt(0)" ::: "memory");
        }
    }
    __syncthreads();
}

struct Args { const float* in[24]; float* out; unsigned char* ws; };
template <class Epi> __device__ __forceinline__ void run_gemm(const Ctx& C, const bf16* A, const bf16* Bt, int N, int K, const Epi& E) {
    pg8::Gemm g{A, Bt, T, N, K}; pg8::StaticOrder S; S.init(T, N, C.G, C.bid);
    pg8::gemm_phase<Epi, pg8::StaticOrder, true, true>(C.lds, g, S, E);
}
__global__ void __launch_bounds__(NTHR, 2) mega_fwd(Args a) {
    extern __shared__ __attribute__((aligned(16))) unsigned char lds_raw[];
    cg::grid_group grid = cg::this_grid();
    Ctx C; C.lds = (LAS unsigned char*)lds_raw; C.G = gridDim.x; C.bid = blockIdx.x;
#define FRESH() do { int t_ = threadIdx.x; asm volatile("" : "+v"(t_)); C.tid = t_; C.lane = t_ & 63; C.wave = __builtin_amdgcn_readfirstlane(t_ >> 6); } while (0)
    FRESH();
#define GRID_SYNC() do { asm volatile("s_waitcnt vmcnt(0)" ::: "memory"); __syncthreads(); grid.sync(); if (threadIdx.x < 64) { __builtin_amdgcn_fence(__ATOMIC_ACQUIRE, "agent"); asm volatile("s_waitcnt vmcnt(0)" ::: "memory"); } __syncthreads(); } while (0)
    unsigned char* ws = a.ws; unsigned char* act = ws + WS_ACT;
    unsigned* barw = (unsigned*)(ws + 4096);
    volatile LAS unsigned* bst = (volatile LAS unsigned*)(C.lds + 131072 + 64);
    if (C.tid < 2) bst[C.tid] = 0u;
    if (C.bid == 0) for (int i = C.tid; i < XCD_BAR_WORDS; i += NTHR) barw[i] = 0u;
    __syncthreads();
    XcdBarrier xbar; xbar.bar = barw; xbar.x = 0; xbar.st = bst;
#define XSYNC() do { xcd_barrier(xbar); } while (0)
    const float* x = a.in[0]; const int* pos = (const int*)a.in[1];
    float* LB = (float*)(ws + WS_SMALL + SM_LB); float* COSt = (float*)(ws + WS_SMALL + SM_COS); float* SINt = (float*)(ws + WS_SMALL + SM_SIN);
    bf16* KR = (bf16*)(ws + WS_SMALL + SM_KR); float* SSQ = (float*)(ws + WS_SMALL + SM_SSQ);
    bf16* WGU = (bf16*)(ws + WS_WFFGU); bf16* WD = (bf16*)(ws + WS_WFFD); bf16* WIN = (bf16*)(ws + WS_WIN); bf16* WQ = (bf16*)(ws + WS_WQ); bf16* WKV = (bf16*)(ws + WS_WKV);
    bf16* WMO = (bf16*)(ws + WS_WMO); bf16* WHO = (bf16*)(ws + WS_WHO); bf16* WOUT = (bf16*)(ws + WS_WOUT);
    bf16* HN = (bf16*)(act + A_HN); bf16* ACT1 = (bf16*)(act + A_ACT1); bf16* Y1 = (bf16*)(act + A_Y1);
    bf16* CQKV = (bf16*)(act + A_CQKV); bf16* OA = (bf16*)(act + A_OA); bf16* Qb = (bf16*)(act + A_Q); bf16* KN = (bf16*)(act + A_KN); bf16* VT = (bf16*)(act + A_VT);
    bf16* CQN = (bf16*)(act + A_CQN); bf16* CKVN = (bf16*)(act + A_CKVN);
    bf16* HQ = (bf16*)(act + A_HQ); bf16* LOGF = (bf16*)(act + A_LOGF); bf16* HI = (bf16*)(act + A_HI);
    bf16* GA = (bf16*)(act + A_GA); bf16* GB = (bf16*)(act + A_GB); bf16* Y2 = (bf16*)(act + A_Y2);
    bf16* HN3 = (bf16*)(act + A_HN3); bf16* ACT2 = (bf16*)(act + A_ACT2); bf16* Y3 = (bf16*)(act + A_Y3);
    float* out = a.out;

    conv_ffn(C, a.in[3], a.in[4], a.in[5], WGU, WD);
    conv_mixer(C, a.in[8], a.in[10], a.in[12], a.in[13], a.in[16], a.in[17], WIN, WQ, WKV, WMO, WHO, WOUT);
    rows_norm(C, x, a.in[2], HN);
    { const int i = C.bid * NTHR + C.tid; if (i < 2048) { const float* lg = a.in[14]; LB[i] = fsig(lg[i] - lg[2048 + i]); } }
    GRID_SYNC();
    xbar = xcd_barrier_post(barw, bst);
    run_gemm(C, HN, WGU, 11264, D, pg8::EpiSwiGLU{ACT1, FF});
    XSYNC();
    run_gemm(C, ACT1, WD, D, FF, pg8::EpiBf{Y1, D});
    XSYNC();
    FRESH(); rows_update(C, x, Y1, a.in[6], 0.5f, out, a.in[7], HN);
    FRESH(); conv_ffn(C, a.in[20], a.in[21], a.in[22], WGU, WD);
    XSYNC();
    run_gemm(C, HN, WIN + (size_t)12288 * D, 1280, D, pg8::EpiBf{CQKV, 1280});
    XSYNC();
    FRESH(); rows_latent(C, CQKV, a.in[9], a.in[11], pos, CQN, CKVN, KR, COSt, SINt);
    XSYNC();
    run_gemm(C, CQN, WQ, 3072, 512, pg8::EpiQ{Qb, COSt, SINt, 0.07216878364870322f * 1.4426950408889634f});
    run_gemm(C, CKVN, WKV, 4096, 512, pg8::EpiKV{KN, VT});
    XSYNC();
    att::attn_phase(C, Qb, KN, KR, VT, OA);
    XSYNC();
    run_gemm(C, HN, WIN, 6144, D, pg8::EpiH{HQ, LOGF, HI, LB});
    XSYNC();
    hg::scan_phase(C, HQ, LOGF, HI, SSQ);
    XSYNC();
    run_gemm(C, HN, WIN + (size_t)6144 * D, 2048, D, pg8::EpiHG{HI, SSQ, a.in[15], EPS});
    run_gemm(C, HN, WIN + (size_t)8192 * D, 2048, D, pg8::EpiGate{GA, GA});
    run_gemm(C, OA, WMO, D, D, pg8::EpiMix<0>{GA, GB});
    run_gemm(C, HN, WIN + (size_t)10240 * D, 2048, D, pg8::EpiGate{GB, GB});
    XSYNC();
    run_gemm(C, HI, WHO, D, D, pg8::EpiMix<1>{GA, GB});
    XSYNC();
    run_gemm(C, GB, WOUT, D, D, pg8::EpiBf{Y2, D});
    XSYNC();
    FRESH(); rows_update(C, out, Y2, a.in[18], 1.0f, out, a.in[19], HN3);
    XSYNC();
    run_gemm(C, HN3, WGU, 11264, D, pg8::EpiSwiGLU{ACT2, FF});
    XSYNC();
    run_gemm(C, ACT2, WD, D, FF, pg8::EpiBf{Y3, D});
    XSYNC();
    FRESH(); rows_update(C, out, Y3, a.in[23], 0.5f, out, nullptr, nullptr);
}

extern "C" void kernel_launch(void* const* d_in, const int* in_sizes, int n_in, void* d_out, int out_size, void* d_ws, size_t ws_size, hipStream_t stream) {
    static int grid = 0;
    if (grid == 0) {
        if (n_in != 24 || in_sizes[0] != T * D || out_size != T * D || ws_size < WS_END) { fprintf(stderr, "kernel_launch: unexpected shapes / workspace (n_in %d, ws %zu, need %zu)\n", n_in, ws_size, (size_t)WS_END); grid = -1; return; }
        int dev = 0, cus = 0, per_cu = 0;
        hipGetDevice(&dev); hipDeviceGetAttribute(&cus, hipDeviceAttributeMultiprocessorCount, dev);
        if (hipFuncSetAttribute((const void*)mega_fwd, hipFuncAttributeMaxDynamicSharedMemorySize, LDS_BYTES) != hipSuccess) { fprintf(stderr, "kernel_launch: hipFuncSetAttribute failed\n"); grid = -1; return; }
        if (hipOccupancyMaxActiveBlocksPerMultiprocessor(&per_cu, (const void*)mega_fwd, NTHR, LDS_BYTES) != hipSuccess || per_cu < 1) per_cu = 1;
        (void)hipGetLastError();
        grid = cus * 1;
        if (grid <= 0) grid = 256;
    }
    if (grid < 0) return;
    Args a{};
    for (int i = 0; i < 24; ++i) a.in[i] = (const float*)d_in[i];
    a.out = (float*)d_out; a.ws = (unsigned char*)d_ws;
    void* args[] = {&a};
    hipError_t e = hipLaunchCooperativeKernel((const void*)mega_fwd, dim3(grid), dim3(NTHR), args, LDS_BYTES, stream);
    if (e != hipSuccess) fprintf(stderr, "cooperative launch failed: %s (grid %d)\n", hipGetErrorString(e), grid);
}
```

```cpp
#include <hip/hip_runtime.h>
#include <hip/hip_cooperative_groups.h>
#include <cstdio>
#include <cstdint>
namespace cg = cooperative_groups;
namespace pg8 {
#define PG8_LAS __attribute__((address_space(3)))
typedef unsigned short bf16_t;
typedef short bf16x8 __attribute__((ext_vector_type(8)));
typedef float f32x4 __attribute__((ext_vector_type(4)));
typedef unsigned u32x4 __attribute__((ext_vector_type(4)));
constexpr int BM = 256, BK = 64, HALF = 128, HTB = HALF * BK * 2  , STAGE_BYTES = 8 * HTB, NXCD = 8, WGM = 8;

__host__ __device__ __forceinline__ int lds_byte(int r, int c) { const int st = (r >> 4) * 2 + (c >> 5), rr = r & 15, cc = c & 31, ob = rr * 64 + cc * 2; return st * 1024 + (ob ^ (((ob >> 9) & 1) << 5)); }
__host__ __device__ __forceinline__ void stage_rc(int b, int& R, int& C) { const int st = b / 1024, sb = b % 1024, swz = sb ^ (((sb >> 9) & 1) << 5); R = (st >> 1) * 16 + swz / 64; C = (st & 1) * 32 + (swz % 64) / 2; }
__host__ __device__ __forceinline__ int perm32(int rho) { const int n = rho >> 4, i = rho & 15; return 8 * (i >> 2) + 4 * n + (i & 3); }

struct Unit { int pm, pn; };
struct Gemm { const bf16_t* A; const bf16_t* Bt; int M, N, K; };

struct StaticOrder {
    int nM, nN, nwg, G, c;
    __host__ __device__ void init(int M, int N, int G_, int c_) { nM = M / BM; nN = N / BM; nwg = nM * nN; G = G_; c = c_; }
    __host__ __device__ bool next(int i, Unit& u) const {
        const long L = (long)i * G + c; if (L >= nwg) return false;
        int wgid = (int)L; { const int q = nwg / NXCD, r = nwg % NXCD, xcd = wgid % NXCD, off = wgid / NXCD; wgid = (xcd < r ? xcd * (q + 1) : r * (q + 1) + (xcd - r) * q) + off; }
        const int nig = WGM * nN, gid = wgid / nig, fm = gid * WGM, gsz = (nM - fm) < WGM ? (nM - fm) : WGM;
        u.pm = fm + ((wgid % nig) % gsz); u.pn = (wgid % nig) / gsz; return true;
    }
    __device__ __forceinline__ void a_ready(const Unit&) const {}
    __device__ __forceinline__ void done(const Unit&) const {}
};

__device__ __forceinline__ unsigned cvt_pk_bf16(float lo, float hi) { unsigned r; asm volatile("v_cvt_pk_bf16_f32 %0, %1, %2" : "=v"(r) : "v"(lo), "v"(hi)); return r; }
typedef unsigned u32x2 __attribute__((ext_vector_type(2)));
__device__ __forceinline__ float fsigmoid(float x) { return __builtin_amdgcn_rcpf(1.0f + __expf(-x)); }
__device__ __forceinline__ float fsilu(float x) { return x * __builtin_amdgcn_rcpf(1.0f + __expf(-x)); }
__device__ __forceinline__ float bf_lo(unsigned u) { return __uint_as_float(u << 16); }
__device__ __forceinline__ float bf_hi(unsigned u) { return __uint_as_float(u & 0xffff0000u); }
typedef float f32x2c __attribute__((ext_vector_type(2))); typedef __bf16 bf16x2c __attribute__((ext_vector_type(2)));
__device__ __forceinline__ unsigned cvt2(float lo, float hi) { f32x2c v = {lo, hi}; bf16x2c b = __builtin_convertvector(v, bf16x2c); return __builtin_bit_cast(unsigned, b); }
__device__ __forceinline__ u32x4 pack8(const f32x4 v0, const f32x4 v1) { u32x4 w; w.x = cvt2(v0[0], v0[1]); w.y = cvt2(v0[2], v0[3]); w.z = cvt2(v1[0], v1[1]); w.w = cvt2(v1[2], v1[3]); return w; }
__device__ __forceinline__ void unpack8(const u32x4 w, f32x4& v0, f32x4& v1) { v0 = (f32x4){bf_lo(w.x), bf_hi(w.x), bf_lo(w.y), bf_hi(w.y)}; v1 = (f32x4){bf_lo(w.z), bf_hi(w.z), bf_lo(w.w), bf_hi(w.w)}; }

struct EpiSwiGLU {
    static constexpr bool PERM = true, AFTER_DRAIN = false;
    bf16_t* O; int ldc;
    __device__ __forceinline__ void operator()(const f32x4 (&acc)[2][2][4][2], const Unit& u, int wr, int wc, int fr, int fq) const {
        const int row0 = u.pm * BM + wr * 64 + fr, col0 = u.pn * 128 + wc * 32 + 8 * fq;
#pragma unroll
        for (int ai = 0; ai < 2; ++ai)
#pragma unroll
            for (int m = 0; m < 4; ++m) {
                f32x4 v0, v1;
#pragma unroll
                for (int e = 0; e < 4; ++e) { v0[e] = fsilu(acc[ai][0][m][0][e]) * acc[ai][1][m][0][e]; v1[e] = fsilu(acc[ai][0][m][1][e]) * acc[ai][1][m][1][e]; }
                *(u32x4*)(O + (size_t)(row0 + ai * HALF + m * 16) * ldc + col0) = pack8(v0, v1);
            }
    }
};
struct EpiF32 {
    static constexpr bool PERM = false, AFTER_DRAIN = false;
    float* C; int ldc;
    __device__ __forceinline__ void operator()(const f32x4 (&acc)[2][2][4][2], const Unit& u, int wr, int wc, int fr, int fq) const {
        const int row0 = u.pm * BM + wr * 64 + fr, col0 = u.pn * BM + wc * 32 + 4 * fq;
#pragma unroll
        for (int ai = 0; ai < 2; ++ai)
#pragma unroll
            for (int m = 0; m < 4; ++m) { float* rowp = C + (size_t)(row0 + ai * HALF + m * 16) * ldc + col0;
#pragma unroll
                for (int bj = 0; bj < 2; ++bj)
#pragma unroll
                    for (int n = 0; n < 2; ++n) *(f32x4*)(rowp + bj * HALF + n * 16) = acc[ai][bj][m][n]; }
    }
};
struct EpiBf {
    static constexpr bool PERM = true, AFTER_DRAIN = false;
    bf16_t* O; int ldc;
    __device__ __forceinline__ void operator()(const f32x4 (&acc)[2][2][4][2], const Unit& u, int wr, int wc, int fr, int fq) const {
        const int row0 = u.pm * BM + wr * 64 + fr, col0 = u.pn * BM + wc * 32 + 8 * fq;
#pragma unroll
        for (int ai = 0; ai < 2; ++ai)
#pragma unroll
            for (int m = 0; m < 4; ++m) { bf16_t* rowp = O + (size_t)(row0 + ai * HALF + m * 16) * ldc + col0;
#pragma unroll
                for (int bj = 0; bj < 2; ++bj) *(u32x4*)(rowp + bj * HALF) = pack8(acc[ai][bj][m][0], acc[ai][bj][m][1]); }
    }
};
struct EpiKV {
    static constexpr bool PERM = true, AFTER_DRAIN = false;
    bf16_t* KN; bf16_t* VN;
    __device__ __forceinline__ void operator()(const f32x4 (&acc)[2][2][4][2], const Unit& u, int wr, int wc, int fr, int fq) const {
        const int row0 = u.pm * BM + wr * 64 + fr, d0 = wc * 32 + 8 * fq, head = u.pn;
#pragma unroll
        for (int ai = 0; ai < 2; ++ai)
#pragma unroll
            for (int m = 0; m < 4; ++m) { const size_t off = (size_t)(row0 + ai * HALF + m * 16) * 2048 + head * 128 + d0;
                *(u32x4*)(KN + off) = pack8(acc[ai][0][m][0], acc[ai][0][m][1]);
                *(u32x4*)(VN + off) = pack8(acc[ai][1][m][0], acc[ai][1][m][1]); }
    }
};
struct EpiQ {
    static constexpr bool PERM = true, AFTER_DRAIN = false;
    bf16_t* Q; const float* COS; const float* SIN; float qscale;
    __device__ __forceinline__ void operator()(const f32x4 (&acc)[2][2][4][2], const Unit& u, int wr, int wc, int fr, int fq) const {
        const int row0 = u.pm * BM + wr * 64 + fr;
        if (u.pn < 8) {
#pragma unroll
            for (int ai = 0; ai < 2; ++ai)
#pragma unroll
                for (int m = 0; m < 4; ++m) { const int row = row0 + ai * HALF + m * 16;
#pragma unroll
                    for (int bj = 0; bj < 2; ++bj) *(u32x4*)(Q + (size_t)row * 3072 + (2 * u.pn + bj) * 192 + wc * 32 + 8 * fq) = pack8(acc[ai][bj][m][0] * qscale, acc[ai][bj][m][1] * qscale); }
        } else {
            const int head = 4 * (u.pn - 8) + wc;
#pragma unroll
            for (int ai = 0; ai < 2; ++ai)
#pragma unroll
                for (int m = 0; m < 4; ++m) { const int row = row0 + ai * HALF + m * 16;
                    const f32x4 c0 = *(const f32x4*)(COS + (size_t)row * 32 + 8 * fq), c1 = *(const f32x4*)(COS + (size_t)row * 32 + 8 * fq + 4);
                    const f32x4 s0 = *(const f32x4*)(SIN + (size_t)row * 32 + 8 * fq), s1 = *(const f32x4*)(SIN + (size_t)row * 32 + 8 * fq + 4);
                    const f32x4 a0 = acc[ai][0][m][0] * qscale, a1 = acc[ai][0][m][1] * qscale, b0 = acc[ai][1][m][0] * qscale, b1 = acc[ai][1][m][1] * qscale;
                    const f32x4 o10 = a0 * c0 - b0 * s0, o11 = a1 * c1 - b1 * s1, o20 = a0 * s0 + b0 * c0, o21 = a1 * s1 + b1 * c1;
                    bf16_t* qp = Q + (size_t)row * 3072 + head * 192 + 128 + 8 * fq;
                    *(u32x4*)(qp) = pack8(o10, o11); *(u32x4*)(qp + 32) = pack8(o20, o21); }
        }
    }
};
struct EpiH {
    static constexpr bool PERM = true, AFTER_DRAIN = false;
    bf16_t* HQ; bf16_t* LOGF; bf16_t* HI; const float* LB;
    __device__ __forceinline__ void operator()(const f32x4 (&acc)[2][2][4][2], const Unit& u, int wr, int wc, int fr, int fq) const {
        const int row0 = u.pm * BM + wr * 64 + fr; const int seg = u.pn >> 3, col0 = (u.pn & 7) * BM + wc * 32 + 8 * fq;
        if (seg == 1) {
#pragma unroll
            for (int bj = 0; bj < 2; ++bj) { const f32x4 l0 = *(const f32x4*)(LB + col0 + bj * HALF), l1 = *(const f32x4*)(LB + col0 + bj * HALF + 4);
#pragma unroll
                for (int ai = 0; ai < 2; ++ai)
#pragma unroll
                    for (int m = 0; m < 4; ++m) { bf16_t* p = LOGF + (size_t)(row0 + ai * HALF + m * 16) * 2048 + col0 + bj * HALF; f32x4 v0, v1;
#pragma unroll
                        for (int e = 0; e < 4; ++e) { v0[e] = __logf(l0[e] + (1.0f - l0[e]) * fsigmoid(acc[ai][bj][m][0][e])); v1[e] = __logf(l1[e] + (1.0f - l1[e]) * fsigmoid(acc[ai][bj][m][1][e])); }
                        *(u32x4*)p = pack8(v0, v1); } }
        } else {
            bf16_t* O = seg == 0 ? HQ : HI;
#pragma unroll
            for (int ai = 0; ai < 2; ++ai)
#pragma unroll
                for (int m = 0; m < 4; ++m) { bf16_t* rowp = O + (size_t)(row0 + ai * HALF + m * 16) * 2048 + col0;
#pragma unroll
                    for (int bj = 0; bj < 2; ++bj) { f32x4 v0 = acc[ai][bj][m][0], v1 = acc[ai][bj][m][1];
                        if (seg == 0) {
#pragma unroll
                            for (int e = 0; e < 4; ++e) { v0[e] = fsilu(v0[e]); v1[e] = fsilu(v1[e]); } }
                        *(u32x4*)(rowp + bj * HALF) = pack8(v0, v1); } }
        }
    }
};
struct EpiHG {
    static constexpr bool PERM = true, AFTER_DRAIN = false;
    bf16_t* OB; const float* SSQ; const float* ONORM; float eps;
    __device__ __forceinline__ void operator()(const f32x4 (&acc)[2][2][4][2], const Unit& u, int wr, int wc, int fr, int fq) const {
        const int row0 = u.pm * BM + wr * 64 + fr, d0 = wc * 32 + 8 * fq;
        const f32x4 w0 = *(const f32x4*)(ONORM + d0), w1 = *(const f32x4*)(ONORM + d0 + 4);
#pragma unroll
        for (int ai = 0; ai < 2; ++ai) {
#pragma unroll
          for (int mp = 0; mp < 2; ++mp) {
            u32x4 ol[4][2]; f32x4 sq[4];
#pragma unroll
            for (int m = 2 * mp; m < 2 * mp + 2; ++m) { const int row = row0 + ai * HALF + m * 16; sq[m] = *(const f32x4*)(SSQ + (size_t)row * 32 + 4 * u.pn);
#pragma unroll
                for (int bj = 0; bj < 2; ++bj) ol[m][bj] = *(const u32x4*)(OB + (size_t)row * 2048 + u.pn * BM + bj * HALF + d0); }
#pragma unroll
            for (int m = 2 * mp; m < 2 * mp + 2; ++m) { const int row = row0 + ai * HALF + m * 16;
#pragma unroll
                for (int bj = 0; bj < 2; ++bj) { const float ss = bj == 0 ? sq[m][0] + sq[m][1] : sq[m][2] + sq[m][3]; const float rstd = __builtin_amdgcn_rsqf(ss * (1.0f / 128.0f) + eps);
                    bf16_t* p = OB + (size_t)row * 2048 + u.pn * BM + bj * HALF + d0; f32x4 o0, o1; unpack8(ol[m][bj], o0, o1);
#pragma unroll
                    for (int e = 0; e < 4; ++e) { o0[e] = o0[e] * rstd * w0[e] * fsilu(acc[ai][bj][m][0][e]); o1[e] = o1[e] * rstd * w1[e] * fsilu(acc[ai][bj][m][1][e]); }
                    *(u32x4*)p = pack8(o0, o1); } }
          }
        }
    }
};
struct EpiGate {
    static constexpr bool PERM = true, AFTER_DRAIN = false;
    bf16_t* GA; bf16_t* GB;
    __device__ __forceinline__ void operator()(const f32x4 (&acc)[2][2][4][2], const Unit& u, int wr, int wc, int fr, int fq) const {
        const int row0 = u.pm * BM + wr * 64 + fr, col0 = (u.pn & 7) * BM + wc * 32 + 8 * fq; bf16_t* O = (u.pn < 8) ? GA : GB;
#pragma unroll
        for (int ai = 0; ai < 2; ++ai)
#pragma unroll
            for (int m = 0; m < 4; ++m) { bf16_t* rowp = O + (size_t)(row0 + ai * HALF + m * 16) * 2048 + col0;
#pragma unroll
                for (int bj = 0; bj < 2; ++bj) { f32x4 v0, v1;
#pragma unroll
                    for (int e = 0; e < 4; ++e) { v0[e] = fsigmoid(acc[ai][bj][m][0][e]); v1[e] = fsigmoid(acc[ai][bj][m][1][e]); }
                    *(u32x4*)(rowp + bj * HALF) = pack8(v0, v1); } }
    }
};
template <int MODE> struct EpiMix {
    static constexpr bool PERM = true, AFTER_DRAIN = false;
    bf16_t* G; bf16_t* G2;
    __device__ __forceinline__ void operator()(const f32x4 (&acc)[2][2][4][2], const Unit& u, int wr, int wc, int fr, int fq) const {
        const int row0 = u.pm * BM + wr * 64 + fr, col0 = u.pn * BM + wc * 32 + 8 * fq;
#pragma unroll
        for (int ai = 0; ai < 2; ++ai) {
#pragma unroll
          for (int mp = 0; mp < 2; ++mp) {
            u32x4 gl[4][2], hl[4][2];
#pragma unroll
            for (int m = 2 * mp; m < 2 * mp + 2; ++m)
#pragma unroll
                for (int bj = 0; bj < 2; ++bj) { const size_t off = (size_t)(row0 + ai * HALF + m * 16) * 2048 + col0 + bj * HALF; gl[m][bj] = *(const u32x4*)(G + off); if (MODE == 1) hl[m][bj] = *(const u32x4*)(G2 + off); }
#pragma unroll
            for (int m = 2 * mp; m < 2 * mp + 2; ++m)
#pragma unroll
                for (int bj = 0; bj < 2; ++bj) { const size_t off = (size_t)(row0 + ai * HALF + m * 16) * 2048 + col0 + bj * HALF; f32x4 g0, g1; unpack8(gl[m][bj], g0, g1);
                    if (MODE == 0) { *(u32x4*)(G + off) = pack8(g0 * acc[ai][bj][m][0], g1 * acc[ai][bj][m][1]); }
                    else { f32x4 h0, h1; unpack8(hl[m][bj], h0, h1); *(u32x4*)(G2 + off) = pack8(g0 + h0 * acc[ai][bj][m][0], g1 + h1 * acc[ai][bj][m][1]); } }
          }
        }
    }
};
template <class Epi, class Sched, bool ALIGN_EPI = false, bool SP2 = false>
__device__ __forceinline__ void gemm_phase(PG8_LAS unsigned char* lds, const Gemm g, const Sched& S, const Epi& E) {
    int tid = threadIdx.x; asm volatile("" : "+v"(tid));
    const int wid = __builtin_amdgcn_readfirstlane(tid >> 6), lane = tid & 63, wr = wid >> 2, wc = wid & 3, fr = lane & 15, fq = lane >> 4;
    const int K = g.K, nt = K / BK;
    unsigned voffA[2], voffB[2];
#pragma unroll
    for (int i = 0; i < 2; ++i) { int R, C; stage_rc(tid * 16 + i * 8192, R, C); const int Rb = Epi::PERM ? ((R & ~31) + perm32(R & 31)) : R;
        voffA[i] = (unsigned)(R * K + C) * 2u; voffB[i] = (unsigned)(Rb * K + C) * 2u; }
    const size_t kstep = (size_t)(BK * 2);
    const size_t hstep = (size_t)HALF * K * 2;
    const size_t tstep = 2 * hstep;
    const unsigned ldsw = (unsigned)wid * 1024u;
    const int aoff = lds_byte(wr * 64 + fr, fq * 8), boff = lds_byte(wc * 32 + fr, fq * 8);
#define PG8_SA(b, h) (((b) * 2 + (h)) * HTB)
#define PG8_SB(b, h) ((4 + (b) * 2 + (h)) * HTB)
#define PG8_STAGE(bufoff, gbase, voff) do { _Pragma("unroll") for (int _i = 0; _i < 2; ++_i) \
        __builtin_amdgcn_global_load_lds((const unsigned*)((const char*)(gbase) + (voff)[_i]), (PG8_LAS unsigned*)(lds + (bufoff) + ldsw + _i * 8192), 16, 0, 0); } while (0)
#define PG8_LDA(dst, b, h) do { _Pragma("unroll") for (int m = 0; m < 4; ++m) _Pragma("unroll") for (int k = 0; k < 2; ++k) dst[m][k] = *(const PG8_LAS bf16x8*)(lds + PG8_SA(b, h) + aoff + m * 2048 + k * 1024); } while (0)
#define PG8_LDB(dst, b, h) do { _Pragma("unroll") for (int n = 0; n < 2; ++n) _Pragma("unroll") for (int k = 0; k < 2; ++k) dst[n][k] = *(const PG8_LAS bf16x8*)(lds + PG8_SB(b, h) + boff + n * 2048 + k * 1024); } while (0)
#define PG8_MMA(ai, bj, At, Bt) do { __builtin_amdgcn_s_setprio(1); _Pragma("unroll") for (int m = 0; m < 4; ++m) _Pragma("unroll") for (int n = 0; n < 2; ++n) _Pragma("unroll") for (int k = 0; k < 2; ++k) \
        acc[ai][bj][m][n] = __builtin_amdgcn_mfma_f32_16x16x32_bf16(Bt[n][k], At[m][k], acc[ai][bj][m][n], 0, 0, 0); __builtin_amdgcn_s_setprio(0); } while (0)
#define PG8_WAIT_V(n) asm volatile("s_waitcnt vmcnt(" #n ")" ::: "memory")
#define PG8_WAIT_L(n) asm volatile("s_waitcnt lgkmcnt(" #n ")" ::: "memory")
#define PG8_BAR __builtin_amdgcn_s_barrier()
#define PG8_SCHED __builtin_amdgcn_sched_barrier(0)
    Unit cur, nxt; int ui = 0;
    if (!S.next(0, cur)) return;
    f32x4 acc[2][2][4][2];
#pragma unroll
    for (int a = 0; a < 2; ++a)
#pragma unroll
        for (int b = 0; b < 2; ++b)
#pragma unroll
            for (int m = 0; m < 4; ++m)
#pragma unroll
                for (int n = 0; n < 2; ++n) acc[a][b][m][n] = (f32x4){0.f, 0.f, 0.f, 0.f};
    bf16x8 At[4][2], B0[2][2], B1[2][2];
    const char* cA = (const char*)g.A + (size_t)cur.pm * tstep; const char* cB = (const char*)g.Bt + (size_t)cur.pn * tstep;
    S.a_ready(cur);
    if constexpr (SP2) {
        PG8_STAGE(PG8_SB(0, 0), cB, voffB); PG8_STAGE(PG8_SB(0, 1), cB + hstep, voffB); PG8_STAGE(PG8_SA(0, 0), cA, voffA); PG8_STAGE(PG8_SA(0, 1), cA + hstep, voffA);
        if (wr == 1) PG8_BAR;
        PG8_WAIT_V(2); PG8_BAR;
        PG8_STAGE(PG8_SB(1, 0), cB + kstep, voffB); PG8_STAGE(PG8_SA(1, 0), cA + kstep, voffA); PG8_STAGE(PG8_SB(1, 1), cB + hstep + kstep, voffB);
        PG8_WAIT_V(6); PG8_BAR;
    } else {
        PG8_STAGE(PG8_SB(0, 0), cB, voffB); PG8_STAGE(PG8_SA(0, 0), cA, voffA); PG8_STAGE(PG8_SB(0, 1), cB + hstep, voffB); PG8_STAGE(PG8_SA(0, 1), cA + hstep, voffA);
        if (wr == 1) PG8_BAR;
        PG8_WAIT_V(4); PG8_BAR;
        PG8_STAGE(PG8_SB(1, 0), cB + kstep, voffB); PG8_STAGE(PG8_SA(1, 0), cA + kstep, voffA); PG8_STAGE(PG8_SB(1, 1), cB + hstep + kstep, voffB);
        PG8_WAIT_V(6); PG8_BAR;
    }
    for (;;) {
        const bool has_next = S.next(ui + 1, nxt);
        const char* nA = has_next ? (const char*)g.A + (size_t)nxt.pm * tstep : cA; const char* nB = has_next ? (const char*)g.Bt + (size_t)nxt.pn * tstep : cB;
        for (int t = 0; t < nt; t += 2) {
            const bool last = (t == nt - 2);
            const char* a1 = cA + (size_t)(t + 1) * kstep;
            const char* a2 = last ? nA : cA + (size_t)(t + 2) * kstep; const char* b2 = last ? nB : cB + (size_t)(t + 2) * kstep;
            const char* a3 = a2 + kstep; const char* b3 = b2 + kstep;
            if (last && has_next) S.a_ready(nxt);
            if constexpr (SP2) {
            PG8_LDB(B0, 0, 0); PG8_LDB(B1, 0, 1); PG8_SCHED; PG8_LDA(At, 0, 0); PG8_STAGE(PG8_SA(1, 1), a1 + hstep, voffA);
            PG8_WAIT_V(8); PG8_WAIT_L(0); PG8_BAR; PG8_MMA(0, 0, At, B0); PG8_MMA(0, 1, At, B1); PG8_BAR; PG8_SCHED;
            PG8_LDA(At, 0, 1); PG8_STAGE(PG8_SB(0, 0), b2, voffB); PG8_STAGE(PG8_SB(0, 1), b2 + hstep, voffB); PG8_STAGE(PG8_SA(0, 0), a2, voffA);
            PG8_WAIT_V(8); PG8_WAIT_L(0); PG8_BAR; PG8_MMA(1, 0, At, B0); PG8_MMA(1, 1, At, B1); PG8_BAR; PG8_SCHED;
            PG8_LDB(B0, 1, 0); PG8_LDB(B1, 1, 1); PG8_SCHED; PG8_LDA(At, 1, 0); PG8_STAGE(PG8_SA(0, 1), a2 + hstep, voffA);
            PG8_WAIT_V(8); PG8_WAIT_L(0); PG8_BAR; PG8_MMA(0, 0, At, B0); PG8_MMA(0, 1, At, B1); PG8_BAR; PG8_SCHED;
            PG8_LDA(At, 1, 1); PG8_STAGE(PG8_SB(1, 0), b3, voffB); PG8_STAGE(PG8_SB(1, 1), b3 + hstep, voffB); PG8_STAGE(PG8_SA(1, 0), a3, voffA);
            PG8_WAIT_V(8); PG8_WAIT_L(0); PG8_BAR; PG8_MMA(1, 0, At, B0); PG8_MMA(1, 1, At, B1); PG8_BAR; PG8_SCHED;
            } else {
            PG8_LDB(B0, 0, 0); PG8_SCHED; PG8_LDA(At, 0, 0); PG8_STAGE(PG8_SA(1, 1), a1 + hstep, voffA);
            PG8_WAIT_L(8); PG8_BAR; PG8_WAIT_L(0); PG8_MMA(0, 0, At, B0); PG8_BAR; PG8_SCHED;
            PG8_LDB(B1, 0, 1); PG8_STAGE(PG8_SB(0, 0), b2, voffB);
            PG8_BAR; PG8_WAIT_L(0); PG8_MMA(0, 1, At, B1); PG8_BAR;
            PG8_LDA(At, 0, 1); PG8_STAGE(PG8_SA(0, 0), a2, voffA);
            PG8_BAR; PG8_WAIT_L(0); PG8_MMA(1, 0, At, B0); PG8_BAR; PG8_SCHED;
            PG8_STAGE(PG8_SB(0, 1), b2 + hstep, voffB);
            PG8_WAIT_V(6); PG8_BAR; PG8_MMA(1, 1, At, B1); PG8_BAR;
            PG8_LDB(B0, 1, 0); PG8_SCHED; PG8_LDA(At, 1, 0); PG8_STAGE(PG8_SA(0, 1), a2 + hstep, voffA);
            PG8_WAIT_L(8); PG8_BAR; PG8_WAIT_L(0); PG8_MMA(0, 0, At, B0); PG8_BAR; PG8_SCHED;
            PG8_LDB(B1, 1, 1); PG8_STAGE(PG8_SB(1, 0), b3, voffB);
            PG8_BAR; PG8_WAIT_L(0); PG8_MMA(0, 1, At, B1); PG8_BAR;
            PG8_LDA(At, 1, 1); PG8_STAGE(PG8_SA(1, 0), a3, voffA);
            PG8_BAR; PG8_WAIT_L(0); PG8_MMA(1, 0, At, B0); PG8_BAR; PG8_SCHED;
            PG8_STAGE(PG8_SB(1, 1), b3 + hstep, voffB);
            PG8_WAIT_V(6); PG8_BAR; PG8_MMA(1, 1, At, B1); PG8_BAR;
            }
        }
        if constexpr (ALIGN_EPI) { if (wr == 0) PG8_BAR; }
        if constexpr (!Epi::AFTER_DRAIN) { E(acc, cur, wr, wc, fr, fq); S.done(cur); }
        if (!has_next) break;
#pragma unroll
        for (int a = 0; a < 2; ++a)
#pragma unroll
            for (int b = 0; b < 2; ++b)
#pragma unroll
                for (int m = 0; m < 4; ++m)
#pragma unroll
                    for (int n = 0; n < 2; ++n) acc[a][b][m][n] = (f32x4){0.f, 0.f, 0.f, 0.f};
        cur = nxt; cA = nA; cB = nB; ++ui;
        if constexpr (ALIGN_EPI) { if (wr == 1) PG8_BAR; }
    }
    PG8_WAIT_V(0);
    if constexpr (!ALIGN_EPI) { if (wr == 0) PG8_BAR; }
    PG8_BAR;
    if constexpr (Epi::AFTER_DRAIN) { E.fused(acc, cur, wr, wc, fr, fq, lds, wid, lane); S.done(cur); }
#undef PG8_SA
#undef PG8_SB
#undef PG8_STAGE
#undef PG8_LDA
#undef PG8_LDB
#undef PG8_MMA
#undef PG8_WAIT_V
#undef PG8_WAIT_L
#undef PG8_BAR
#undef PG8_SCHED
}
}
constexpr int NWAVES = 8, NTHR = 512;
constexpr int T = 16384, D = 2048, FF = 5632, SEQ = 2048, NB = 8, NH = 16;
constexpr float EPS = 1e-6f;
constexpr size_t MiB = 1u << 20, U = 64 * MiB;
constexpr size_t WS_SMALL = 1 * MiB;
constexpr size_t SM_LB = 0, SM_COS = 1 * MiB, SM_SIN = 3 * MiB, SM_KR = 5 * MiB, SM_SSQ = 7 * MiB;
constexpr size_t WS_WFFGU = 11 * MiB;
constexpr size_t WS_WFFD = WS_WFFGU + 44 * MiB;
constexpr size_t WS_WIN = WS_WFFD + 22 * MiB;
constexpr size_t WS_WQ = WS_WIN + 53 * MiB;
constexpr size_t WS_WKV = WS_WQ + 3 * MiB;
constexpr size_t WS_WMO = WS_WKV + 4 * MiB, WS_WHO = WS_WMO + 8 * MiB, WS_WOUT = WS_WHO + 8 * MiB;
constexpr size_t WS_ACT = WS_WOUT + 8 * MiB;
constexpr size_t WS_END = WS_ACT + 6 * U;
constexpr size_t A_HN = 0;
constexpr size_t A_ACT1 = 1 * U;
constexpr size_t A_Y1 = 3 * U + 3 * U / 4;
constexpr size_t A_CQKV = 1 * U, A_OA = 1 * U;
constexpr size_t A_Q = 2 * U, A_KN = 3 * U + U / 2, A_VT = 4 * U + U / 2;
constexpr size_t A_CQN = 5 * U + U / 2, A_CKVN = 5 * U + U / 2 + 16 * MiB;
constexpr size_t A_HQ = 2 * U, A_LOGF = 3 * U, A_HI = 5 * U;
constexpr size_t A_GA = 2 * U, A_GB = 3 * U;
constexpr size_t A_Y2 = 0;
constexpr size_t A_HN3 = 4 * U;
constexpr size_t A_ACT2 = 0;
constexpr size_t A_Y3 = 3 * U;

constexpr int LDS_BYTES = 147456;

#define GAS __attribute__((address_space(1)))
#define LAS __attribute__((address_space(3)))
typedef unsigned short bf16;
typedef unsigned v4u __attribute__((ext_vector_type(4)));
typedef unsigned v2u __attribute__((ext_vector_type(2)));
typedef float f32x4 __attribute__((ext_vector_type(4)));
typedef float f32x16 __attribute__((ext_vector_type(16)));
typedef short bf16x8 __attribute__((ext_vector_type(8)));
typedef short s16x4 __attribute__((ext_vector_type(4)));
typedef short v4i16_t __attribute__((ext_vector_type(4)));
typedef float f32x2_t __attribute__((ext_vector_type(2)));
typedef __bf16 bf16x2_t __attribute__((ext_vector_type(2)));
#define LDS_WAIT() asm volatile("s_waitcnt lgkmcnt(0)" ::: "memory")
#define MFMA32(a, b, c) __builtin_amdgcn_mfma_f32_32x32x16_bf16((a), (b), (c), 0, 0, 0)
__device__ __forceinline__ unsigned f2bf(float f) { unsigned u = __builtin_bit_cast(unsigned, f); return (u + 0x7fffu + ((u >> 16) & 1u)) >> 16; }
__device__ __forceinline__ unsigned pk2(float lo, float hi) { f32x2_t v = {lo, hi}; bf16x2_t b = __builtin_convertvector(v, bf16x2_t); return __builtin_bit_cast(unsigned, b); }
__device__ __forceinline__ float bflo(unsigned u) { return __uint_as_float(u << 16); }
__device__ __forceinline__ float bfhi(unsigned u) { return __uint_as_float(u & 0xffff0000u); }
__device__ __forceinline__ float bf2f(bf16 b) { return __uint_as_float(((unsigned)b) << 16); }
__device__ __forceinline__ float wave_sum(float v) {
#pragma unroll
    for (int o = 1; o < 64; o <<= 1) v += __shfl_xor(v, o);
    return v;
}
__device__ __forceinline__ float fsig(float x) { return __builtin_amdgcn_rcpf(1.0f + __expf(-x)); }

struct Ctx { LAS unsigned char* lds; int tid, lane, wave, G, bid; };

__device__ __forceinline__ void conv_item(const float* W, int K, int N, int scol0, bf16* WT, int drow0, int k0, LAS float* scr, int lane) {
    float wv[32];
    { const float* src = W + (size_t)(k0 + (lane >> 5)) * N + scol0 + (lane & 31);
#pragma unroll
      for (int i = 0; i < 32; ++i) wv[i] = src[(size_t)(2 * i) * N]; }
#pragma unroll
    for (int i = 0; i < 32; ++i) scr[(2 * i + (lane >> 5)) * 33 + (lane & 31)] = wv[i];
    LDS_WAIT(); asm volatile("" ::: "memory");
    const int c = lane & 7;
#pragma unroll
    for (int j = 0; j < 4; ++j) { const int n = (lane >> 3) + 8 * j; const LAS float* s = scr + (8 * c) * 33 + n;
        v4u o; o.x = pk2(s[0 * 33], s[1 * 33]); o.y = pk2(s[2 * 33], s[3 * 33]); o.z = pk2(s[4 * 33], s[5 * 33]); o.w = pk2(s[6 * 33], s[7 * 33]);
        *(GAS v4u*)(WT + (size_t)(drow0 + n) * K + k0 + 8 * c) = o; }
    LDS_WAIT(); asm volatile("" ::: "memory");
}
__device__ __forceinline__ void zero_item(bf16* WT, int K, int drow0, int k0, int lane) {
    const int c = lane & 7;
#pragma unroll
    for (int j = 0; j < 4; ++j) { const int n = (lane >> 3) + 8 * j; *(GAS v4u*)(WT + (size_t)(drow0 + n) * K + k0 + 8 * c) = (v4u){0u, 0u, 0u, 0u}; }
}
__device__ __forceinline__ void conv_ffn(const Ctx& C, const float* wg, const float* wu, const float* wd, bf16* WGU, bf16* WD, int b0 = 0) {
    LAS float* scr = (LAS float*)(C.lds + C.wave * 16384);
    const int gw = (C.bid - b0) * NWAVES + C.wave, NGW = (C.G - b0) * NWAVES;
    if (C.bid < b0) return;
    constexpr int KB1 = D / 64, I_GU = (11264 / 32) * KB1, KB2 = FF / 64, I_D = (D / 32) * KB2;
    for (int it = gw; it < I_GU + I_D; it += NGW) {
        if (it < I_GU) { const int g = it / KB1, kb = it % KB1; const int tile = g >> 3, w = (g & 7) * 32;
            const float* src = (w < 128) ? wg : wu; const int scol = tile * 128 + (w & 127);
            conv_item(src, D, FF, scol, WGU, 32 * g, 64 * kb, scr, C.lane); }
        else { const int r = it - I_GU; const int g = r / KB2, kb = r % KB2; conv_item(wd, FF, D, 32 * g, WD, 32 * g, 64 * kb, scr, C.lane); }
    }
}
__device__ __forceinline__ void conv_mixer(const Ctx& C, const float* w_in, const float* wq, const float* wkv, const float* wmo, const float* who, const float* wout,
                                           bf16* WIN, bf16* WQ, bf16* WKV, bf16* WMO, bf16* WHO, bf16* WOUT) {
    LAS float* scr = (LAS float*)(C.lds + C.wave * 16384);
    const int gw = C.bid * NWAVES + C.wave, NGW = C.G * NWAVES;
    constexpr int KB = D / 64  , KBL = 512 / 64  ;
    constexpr int I_IN = (13568 / 32) * KB, I_Q = (3072 / 32) * KBL, I_KV = (4096 / 32) * KBL, I_SQ = (2048 / 32) * KB;
    for (int it = gw; it < I_IN + I_Q + I_KV + 3 * I_SQ; it += NGW) {
        int r = it;
        if (r < I_IN) { const int g = r / KB, kb = r % KB; const int drow = 32 * g;
            if (drow < 12288) conv_item(w_in, D, 13376, 1088 + drow, WIN, drow, 64 * kb, scr, C.lane);
            else if (drow < 12288 + 1088) conv_item(w_in, D, 13376, drow - 12288, WIN, drow, 64 * kb, scr, C.lane);
            else zero_item(WIN, D, drow, 64 * kb, C.lane);
            continue; }
        r -= I_IN;
        if (r < I_Q) { const int g = r / KBL, kb = r % KBL; const int drow = 32 * g, pn = drow >> 8, w = drow & 255; int scol;
            if (pn < 8) scol = (2 * pn + (w >> 7)) * 192 + (w & 127);
            else { const int head = 4 * (pn - 8) + ((w & 127) >> 5); scol = head * 192 + 128 + ((w >> 7) ? 32 : 0); }
            conv_item(wq, 512, 3072, scol, WQ, drow, 64 * kb, scr, C.lane); continue; }
        r -= I_Q;
        if (r < I_KV) { const int g = r / KBL, kb = r % KBL; conv_item(wkv, 512, 4096, 32 * g, WKV, 32 * g, 64 * kb, scr, C.lane); continue; }
        r -= I_KV;
        { const int which = r / I_SQ; r -= which * I_SQ; const int g = r / KB, kb = r % KB;
          const float* src = which == 0 ? wmo : (which == 1 ? who : wout); bf16* dst = which == 0 ? WMO : (which == 1 ? WHO : WOUT);
          conv_item(src, D, D, 32 * g, dst, 32 * g, 64 * kb, scr, C.lane); }
    }
}

__device__ __forceinline__ void rows_norm(const Ctx& C, const float* x, const float* w, bf16* HN) {
    const int gw = C.bid * NWAVES + C.wave, NGW = C.G * NWAVES;
    for (int m = gw; m < T; m += NGW) {
        const GAS f32x4* xr = (const GAS f32x4*)(x + (size_t)m * D) + C.lane; f32x4 v[8]; float s = 0.f;
#pragma unroll
        for (int j = 0; j < 8; ++j) { v[j] = xr[64 * j]; s += (v[j].x * v[j].x + v[j].y * v[j].y) + (v[j].z * v[j].z + v[j].w * v[j].w); }
        const float rstd = 1.0f / sqrtf(wave_sum(s) * (1.0f / D) + EPS);
        GAS v2u* o = (GAS v2u*)(HN + (size_t)m * D) + C.lane;
#pragma unroll
        for (int j = 0; j < 8; ++j) { const f32x4 ww = *((const GAS f32x4*)w + C.lane + 64 * j); o[64 * j] = (v2u){pk2(v[j].x * rstd * ww.x, v[j].y * rstd * ww.y), pk2(v[j].z * rstd * ww.z, v[j].w * rstd * ww.w)}; }
    }
}
__device__ __forceinline__ void rows_update(const Ctx& C, const float* xin, const bf16* Y, const float* wpost, float scale, float* xout, const float* wpre, bf16* HN) {
    const int gw = C.bid * NWAVES + C.wave, NGW = C.G * NWAVES;
    for (int m = gw; m < T; m += NGW) {
        const GAS v2u* yr = (const GAS v2u*)(Y + (size_t)m * D) + C.lane; const GAS f32x4* xr = (const GAS f32x4*)(xin + (size_t)m * D) + C.lane;
        f32x4 v[8]; float s = 0.f;
#pragma unroll
        for (int j = 0; j < 8; ++j) { const v2u w = yr[64 * j]; v[j] = (f32x4){bflo(w.x), bfhi(w.x), bflo(w.y), bfhi(w.y)}; s += (v[j].x * v[j].x + v[j].y * v[j].y) + (v[j].z * v[j].z + v[j].w * v[j].w); }
        const float rstd = scale / sqrtf(wave_sum(s) * (1.0f / D) + EPS);
        GAS f32x4* xo = (GAS f32x4*)(xout + (size_t)m * D) + C.lane; float s2 = 0.f;
#pragma unroll
        for (int j = 0; j < 8; ++j) { const f32x4 ww = *((const GAS f32x4*)wpost + C.lane + 64 * j); const f32x4 xv = xr[64 * j];
            v[j] = xv + v[j] * rstd * ww; xo[64 * j] = v[j]; s2 += (v[j].x * v[j].x + v[j].y * v[j].y) + (v[j].z * v[j].z + v[j].w * v[j].w); }
        if (wpre) { const float r2 = 1.0f / sqrtf(wave_sum(s2) * (1.0f / D) + EPS);
            GAS v2u* o = (GAS v2u*)(HN + (size_t)m * D) + C.lane;
#pragma unroll
            for (int j = 0; j < 8; ++j) { const f32x4 ww = *((const GAS f32x4*)wpre + C.lane + 64 * j); o[64 * j] = (v2u){pk2(v[j].x * r2 * ww.x, v[j].y * r2 * ww.y), pk2(v[j].z * r2 * ww.z, v[j].w * r2 * ww.w)}; } }
    }
}
__device__ __forceinline__ void rows_latent(const Ctx& C, const bf16* CQKV, const float* qn, const float* kvn, const int* pos, bf16* CQN, bf16* CKVN, bf16* KR, float* COSt, float* SINt) {
    const int gw = C.bid * NWAVES + C.wave, NGW = C.G * NWAVES;
    const float invf = __builtin_amdgcn_exp2f(-(float)(C.lane & 31) * (13.287712379549449f / 32.0f));
    for (int m = gw; m < T; m += NGW) {
        const bf16* rowp = CQKV + (size_t)m * 1280;
#pragma unroll
        for (int part = 0; part < 2; ++part) {
            const GAS v4u* p = (const GAS v4u*)(rowp + part * 512) + C.lane; const v4u w = *p;
            float f[8] = {bflo(w.x), bfhi(w.x), bflo(w.y), bfhi(w.y), bflo(w.z), bfhi(w.z), bflo(w.w), bfhi(w.w)}; float s = 0.f;
#pragma unroll
            for (int e = 0; e < 8; ++e) s += f[e] * f[e];
            const float rstd = 1.0f / sqrtf(wave_sum(s) * (1.0f / 512.0f) + EPS);
            const float* nw = (part == 0 ? qn : kvn) + 8 * C.lane; const f32x4 n0 = *(const GAS f32x4*)nw, n1 = *(const GAS f32x4*)(nw + 4);
            v4u o; o.x = pk2(f[0] * rstd * n0.x, f[1] * rstd * n0.y); o.y = pk2(f[2] * rstd * n0.z, f[3] * rstd * n0.w); o.z = pk2(f[4] * rstd * n1.x, f[5] * rstd * n1.y); o.w = pk2(f[6] * rstd * n1.z, f[7] * rstd * n1.w);
            *((GAS v4u*)((part == 0 ? CQN : CKVN) + (size_t)m * 512) + C.lane) = o;
        }
        if (C.lane < 32) {
            const float ang = (float)pos[m] * invf;
            const double turns = (double)ang * 0.15915494309189535; const float fr = (float)(turns - __builtin_rint(turns));
            const float cs = __builtin_amdgcn_cosf(fr), sn = __builtin_amdgcn_sinf(fr);
            const float a = bf2f(rowp[1024 + C.lane]), b = bf2f(rowp[1056 + C.lane]);
            KR[(size_t)m * 64 + C.lane] = (bf16)f2bf(a * cs - b * sn); KR[(size_t)m * 64 + 32 + C.lane] = (bf16)f2bf(a * sn + b * cs);
            COSt[(size_t)m * 32 + C.lane] = cs; SINt[(size_t)m * 32 + C.lane] = sn;
        }
    }
}

namespace att {
constexpr int KP = 200, VP = 160;
constexpr int KT_B = 64 * KP * 2, VT_B = 64 * VP * 2, BUF_B = KT_B + VT_B;
static_assert(2 * BUF_B <= 131072, "attention LDS");
__device__ __forceinline__ void attn_unit(const Ctx& C, int b, int h, int qb, const bf16* Q, const bf16* KN, const bf16* KR, const bf16* VT, bf16* OA) {
    int tid = threadIdx.x; asm volatile("" : "+v"(tid));
    const int lane = tid & 63, r = lane & 31, hh = lane >> 5, w = __builtin_amdgcn_readfirstlane(tid >> 6);
    const int qrow0 = qb * 256 + 32 * w;
    const size_t tok0 = (size_t)b * SEQ;
    bf16x8 qf[12];
    { const bf16* qp = Q + (tok0 + qrow0 + r) * 3072 + h * 192 + 8 * hh;
#pragma unroll
      for (int s = 0; s < 12; ++s) qf[s] = *(const GAS bf16x8*)(qp + 16 * s); }
    f32x16 o[4];
#pragma unroll
    for (int d = 0; d < 4; ++d)
#pragma unroll
        for (int i = 0; i < 16; ++i) o[d][i] = 0.f;
    float mrow = -1e30f, lrow = 0.f;
    const int nkt = (qb + 1) * 4;
    int kkey[3], kpart[3];
#pragma unroll
    for (int i = 0; i < 3; ++i) { const int p = tid + 512 * i; kkey[i] = p / 24; kpart[i] = p % 24; }
    const bf16* vsrc[2]; int vdst[2];
#pragma unroll
    for (int i = 0; i < 2; ++i) { const int p = tid + 512 * i, key = p >> 4, part = p & 15; vsrc[i] = VT + (tok0 + key) * 2048 + h * 128 + part * 8; vdst[i] = key * VP * 2 + part * 16; }
    const int vtr0 = (4 * hh + ((lane & 15) >> 2)) * (VP * 2) + (16 * ((lane >> 4) & 1) + 4 * (lane & 3)) * 2;
    v4u kreg[3], vreg[2];
#define ATT_LOAD(kt) do { const int k0_ = (kt) * 64; _Pragma("unroll") for (int i = 0; i < 3; ++i) { const size_t tk = tok0 + k0_ + kkey[i]; \
        kreg[i] = (kpart[i] < 16) ? *(const GAS v4u*)(KN + tk * 2048 + h * 128 + kpart[i] * 8) : *(const GAS v4u*)(KR + tk * 64 + (kpart[i] - 16) * 8); } \
        _Pragma("unroll") for (int i = 0; i < 2; ++i) vreg[i] = *(const GAS v4u*)(vsrc[i] + (size_t)k0_ * 2048); } while (0)
#define ATT_STORE(buf) do { LAS unsigned char* kb_ = C.lds + (buf) * BUF_B; _Pragma("unroll") for (int i = 0; i < 3; ++i) *(LAS v4u*)(kb_ + kkey[i] * (KP * 2) + kpart[i] * 16) = kreg[i]; \
        _Pragma("unroll") for (int i = 0; i < 2; ++i) *(LAS v4u*)(kb_ + KT_B + vdst[i]) = vreg[i]; } while (0)
    ATT_LOAD(0); ATT_STORE(0);
    __syncthreads();
    for (int kt = 0; kt < nkt; ++kt) {
        const bool more = kt + 1 < nkt;
        if (more) ATT_LOAD(kt + 1);
        const int k0 = kt * 64;
        if (k0 <= qrow0 + 31) {
            const LAS unsigned char* kb = C.lds + (kt & 1) * BUF_B; const LAS unsigned char* vb = kb + KT_B;
            f32x16 s0, s1;
#pragma unroll
            for (int i = 0; i < 16; ++i) { s0[i] = 0.f; s1[i] = 0.f; }
#pragma unroll
            for (int s = 0; s < 12; ++s) {
                const bf16x8 a0 = *(const LAS bf16x8*)(kb + r * (KP * 2) + s * 32 + hh * 16);
                const bf16x8 a1 = *(const LAS bf16x8*)(kb + (32 + r) * (KP * 2) + s * 32 + hh * 16);
                s0 = MFMA32(a0, qf[s], s0); s1 = MFMA32(a1, qf[s], s1);
                if ((s & 1) == 1) __builtin_amdgcn_sched_barrier(0);
            }
            if (k0 + 63 > qrow0) {
                const int qpos = qrow0 + r;
#pragma unroll
                for (int i = 0; i < 16; ++i) { const int key = k0 + (i & 3) + 8 * (i >> 2) + 4 * hh; if (key > qpos) s0[i] = -1e30f; if (key + 32 > qpos) s1[i] = -1e30f; }
            }
            float mx = s0[0];
#pragma unroll
            for (int i = 1; i < 16; ++i) mx = fmaxf(mx, s0[i]);
#pragma unroll
            for (int i = 0; i < 16; ++i) mx = fmaxf(mx, s1[i]);
            mx = fmaxf(mx, __shfl_xor(mx, 32));
            const bool need = mx > mrow + 8.0f;
            if (__builtin_amdgcn_ballot_w64(need) != 0ull) {
                const float mnew = need ? mx : mrow, alpha = __builtin_amdgcn_exp2f(mrow - mnew);
                lrow *= alpha; mrow = mnew;
#pragma unroll
                for (int d = 0; d < 4; ++d)
#pragma unroll
                    for (int i = 0; i < 16; ++i) o[d][i] *= alpha;
            }
            float ps = 0.f;
#pragma unroll
            for (int i = 0; i < 16; ++i) { s0[i] = __builtin_amdgcn_exp2f(s0[i] - mrow); s1[i] = __builtin_amdgcn_exp2f(s1[i] - mrow); ps += s0[i] + s1[i]; }
            lrow += ps;
#pragma unroll
            for (int kt2 = 0; kt2 < 2; ++kt2)
#pragma unroll
                for (int sp = 0; sp < 2; ++sp) {
                    const f32x16& sv = kt2 == 0 ? s0 : s1;
                    v4u pw; pw.x = pk2(sv[8 * sp + 0], sv[8 * sp + 1]); pw.y = pk2(sv[8 * sp + 2], sv[8 * sp + 3]); pw.z = pk2(sv[8 * sp + 4], sv[8 * sp + 5]); pw.w = pk2(sv[8 * sp + 6], sv[8 * sp + 7]);
                    const bf16x8 pb = __builtin_bit_cast(bf16x8, pw);
#pragma unroll
                    for (int d = 0; d < 4; ++d) {
                        const LAS unsigned char* vp = vb + vtr0 + (kt2 * 32 + 16 * sp) * (VP * 2) + 64 * d;
                        const s16x4 lo = __builtin_bit_cast(s16x4, __builtin_amdgcn_ds_read_tr16_b64_v4i16((LAS v4i16_t*)vp)), hi = __builtin_bit_cast(s16x4, __builtin_amdgcn_ds_read_tr16_b64_v4i16((LAS v4i16_t*)(vp + 8 * VP * 2)));
                        const bf16x8 a = __builtin_shufflevector(lo, hi, 0, 1, 2, 3, 4, 5, 6, 7);
                        o[d] = MFMA32(a, pb, o[d]);
                    }
                    __builtin_amdgcn_sched_barrier(0);
                }
        }
        if (more) ATT_STORE((kt + 1) & 1);
        __syncthreads();
    }
#undef ATT_LOAD
#undef ATT_STORE
    const float ltot = lrow + __shfl_xor(lrow, 32), inv = 1.0f / ltot;
    bf16* op = OA + (tok0 + qrow0 + r) * 2048 + h * 128 + 4 * hh;
#pragma unroll
    for (int d = 0; d < 4; ++d)
#pragma unroll
        for (int g = 0; g < 4; ++g)
            *(GAS v2u*)(op + 32 * d + 8 * g) = (v2u){pk2(o[d][4 * g] * inv, o[d][4 * g + 1] * inv), pk2(o[d][4 * g + 2] * inv, o[d][4 * g + 3] * inv)};
}
__device__ __forceinline__ void attn_phase(const Ctx& C, const bf16* Q, const bf16* KN, const bf16* KR, const bf16* VT, bf16* OA) {
    for (int p = C.bid; p < 512; p += C.G) {
        const int bh = p >> 2, j = p & 3, b = bh >> 4, h = bh & 15;
        attn_unit(C, b, h, 7 - j, Q, KN, KR, VT, OA);
        attn_unit(C, b, h, j, Q, KN, KR, VT, OA);
    }
}
}

namespace hg {
constexpr int P128 = 136, P64 = 72, PL = 132;
constexpr int O_QD = 0, O_QT = O_QD + 64 * P128 * 2, O_KT = O_QT + 64 * P128 * 2, O_ST = O_KT + 64 * P128 * 2;
constexpr int O_KDT = O_ST + 64 * P128 * 2;
constexpr int PV = 96;
constexpr int O_VT = O_KDT + 128 * P64 * 2;
constexpr int O_SC = O_VT + 64 * PV * 2;
constexpr int O_G = O_SC + 64 * P64 * 2;
constexpr int O_SEG = O_G + 512;
constexpr int O_OT = O_SEG + 4096;
constexpr int O_END = O_OT + 64 * P64 * 2;
constexpr int O_RQ = 0, O_RL = O_RQ + 64 * P128 * 2;
static_assert(O_RL + 64 * P128 * 2 <= O_ST && O_END <= 131072, "scan LDS");
__device__ __forceinline__ bf16x8 vtr8(const LAS unsigned char* p) { const s16x4 lo = __builtin_bit_cast(s16x4, __builtin_amdgcn_ds_read_tr16_b64_v4i16((LAS v4i16_t*)p)), hi = __builtin_bit_cast(s16x4, __builtin_amdgcn_ds_read_tr16_b64_v4i16((LAS v4i16_t*)(p + 4 * PV * 2))); return __builtin_shufflevector(lo, hi, 0, 1, 2, 3, 4, 5, 6, 7); }
__device__ __forceinline__ void scan_item(const Ctx& C, int b, int h, int half, const bf16* HQ, const bf16* LOGF, bf16* HI  , float* SSQ) {
    int tid = threadIdx.x; asm volatile("" : "+v"(tid));
    const int lane = tid & 63, r = lane & 31, hh = lane >> 5, w = __builtin_amdgcn_readfirstlane(tid >> 6);
    LAS unsigned char* L = C.lds;
    const size_t tokb = (size_t)b * SEQ;
    for (int i = tid; i < 64 * P128 / 2; i += NTHR) ((LAS unsigned*)(L + O_ST))[i] = 0u;
    f32x16 sacc;
#pragma unroll
    for (int i = 0; i < 16; ++i) sacc[i] = 0.f;
    const int vtrs = ((8 * hh + ((lane & 15) >> 2)) * PV + 16 * ((lane >> 4) & 1) + 4 * (lane & 3)) * 2;
    const int kt_own = w >> 1, di_own = w & 1;
    const int vt_t = tid >> 3, vt_d = (tid & 7) * 8;
    v4u rq[2], rl[2], rv;
#define HG_LOAD(c) do { const size_t t0_ = tokb + (size_t)(c) * 64; \
        _Pragma("unroll") for (int i = 0; i < 2; ++i) { const int p_ = tid + 512 * i; rq[i] = *(const GAS v4u*)(HQ + (t0_ + (p_ >> 4)) * 2048 + h * 128 + (p_ & 15) * 8); } \
        _Pragma("unroll") for (int i = 0; i < 2; ++i) { const int p_ = tid + 512 * i; rl[i] = *(const GAS v4u*)(LOGF + (t0_ + (p_ >> 4)) * 2048 + h * 128 + (p_ & 15) * 8); } \
        rv = *(const GAS v4u*)(HI + (t0_ + vt_t) * 2048 + h * 128 + half * 64 + vt_d); } while (0)
#define HG_STORE_O(c) do { const v4u ov_ = *(const LAS v4u*)(L + O_OT + (vt_t * P64 + vt_d) * 2); \
        float sq_ = bflo(ov_.x) * bflo(ov_.x) + bfhi(ov_.x) * bfhi(ov_.x) + bflo(ov_.y) * bflo(ov_.y) + bfhi(ov_.y) * bfhi(ov_.y) + bflo(ov_.z) * bflo(ov_.z) + bfhi(ov_.z) * bfhi(ov_.z) + bflo(ov_.w) * bflo(ov_.w) + bfhi(ov_.w) * bfhi(ov_.w); \
        sq_ += __shfl_xor(sq_, 1); sq_ += __shfl_xor(sq_, 2); sq_ += __shfl_xor(sq_, 4); \
        const size_t tk_ = tokb + (size_t)(c) * 64 + vt_t; *(GAS v4u*)(HI + tk_ * 2048 + h * 128 + half * 64 + vt_d) = ov_; \
        if ((tid & 7) == 0) SSQ[tk_ * 32 + h * 2 + half] = sq_; } while (0)
    HG_LOAD(0);
    for (int c = 0; c < SEQ / 64; ++c) {
#pragma unroll
        for (int i = 0; i < 2; ++i) { const int p_ = tid + 512 * i; *(LAS v4u*)(L + O_RQ + ((p_ >> 4) * P128 + (p_ & 15) * 8) * 2) = rq[i]; }
#pragma unroll
        for (int i = 0; i < 2; ++i) { const int p_ = tid + 512 * i; *(LAS v4u*)(L + O_RL + ((p_ >> 4) * P128 + (p_ & 15) * 8) * 2) = rl[i]; }
        *(LAS v4u*)(L + O_VT + (vt_t * PV + vt_d) * 2) = rv;
        if (c > 0) HG_STORE_O(c - 1);
        if (c + 1 < SEQ / 64) HG_LOAD(c + 1);
        __syncthreads();
        const int k0 = 2 * (tid & 63);
        float q0[8], q1[8], c0[8], c1[8], kk0[8], kk1[8];
        { float r0 = 0.f, r1 = 0.f;
#pragma unroll
          for (int i = 0; i < 8; ++i) { const int t = 8 * w + i; const unsigned lw = *(const LAS unsigned*)(L + O_RL + (t * P128 + k0) * 2); const unsigned qq = *(const LAS unsigned*)(L + O_RQ + (t * P128 + k0) * 2);
              const float l0 = bflo(lw) * 1.4426950408889634f, l1 = bfhi(lw) * 1.4426950408889634f; q0[i] = bflo(qq); q1[i] = bfhi(qq); r0 += l0; r1 += l1; c0[i] = r0; c1[i] = r1;
              kk0[i] = 1.0f - __builtin_amdgcn_exp2f(l0); kk1[i] = 1.0f - __builtin_amdgcn_exp2f(l1); }
          *(LAS f32x2_t*)(L + O_SEG + (w * 128 + k0) * 4) = (f32x2_t){r0, r1}; }
        __syncthreads();
        { float pre0 = 0.f, pre1 = 0.f, mid0 = 0.f, mid1 = 0.f, tot0 = 0.f, tot1 = 0.f;
#pragma unroll
          for (int s8 = 0; s8 < 8; ++s8) { const f32x2_t sv = *(const LAS f32x2_t*)(L + O_SEG + (s8 * 128 + k0) * 4); if (s8 < w) { pre0 += sv.x; pre1 += sv.y; } if (s8 < 4) { mid0 += sv.x; mid1 += sv.y; } tot0 += sv.x; tot1 += sv.y; }
          if (w == 0) *(LAS f32x2_t*)(L + O_G + k0 * 4) = (f32x2_t){__builtin_amdgcn_exp2f(tot0), __builtin_amdgcn_exp2f(tot1)};
          const float cm0 = __builtin_amdgcn_exp2f(fminf(-mid0, 115.f)), cm1 = __builtin_amdgcn_exp2f(fminf(-mid1, 115.f));
          float kd0[8], kd1[8];
#pragma unroll
          for (int i = 0; i < 8; ++i) { const int t = 8 * w + i; const float b0 = pre0 + c0[i], b1 = pre1 + c1[i];
              const float e0 = __builtin_amdgcn_exp2f(b0), e1 = __builtin_amdgcn_exp2f(b1);
              const float qd0 = q0[i] * e0, qd1 = q1[i] * e1, qt0 = qd0 * cm0, qt1 = qd1 * cm1;
              const float kt0 = kk0[i] * __builtin_amdgcn_exp2f(fminf(mid0 - b0, 115.f)), kt1 = kk1[i] * __builtin_amdgcn_exp2f(fminf(mid1 - b1, 115.f));
              kd0[i] = kk0[i] * __builtin_amdgcn_exp2f(tot0 - b0); kd1[i] = kk1[i] * __builtin_amdgcn_exp2f(tot1 - b1);
              *(LAS unsigned*)(L + O_QD + (t * P128 + k0) * 2) = pk2(qd0, qd1); *(LAS unsigned*)(L + O_QT + (t * P128 + k0) * 2) = pk2(qt0, qt1); *(LAS unsigned*)(L + O_KT + (t * P128 + k0) * 2) = pk2(kt0, kt1); }
          *(LAS v4u*)(L + O_KDT + (k0 * P64 + 8 * w) * 2) = (v4u){pk2(kd0[0], kd0[1]), pk2(kd0[2], kd0[3]), pk2(kd0[4], kd0[5]), pk2(kd0[6], kd0[7])};
          *(LAS v4u*)(L + O_KDT + ((k0 + 1) * P64 + 8 * w) * 2) = (v4u){pk2(kd1[0], kd1[1]), pk2(kd1[2], kd1[3]), pk2(kd1[4], kd1[5]), pk2(kd1[6], kd1[7])}; }
        __syncthreads();
        f32x16 acc;
#pragma unroll
        for (int i = 0; i < 16; ++i) acc[i] = 0.f;
        const int ti = (w & 3) >> 1, xi = w & 1;
        if (w < 4) {
            if (xi <= ti) {
#pragma unroll
                for (int s = 0; s < 8; ++s) { const bf16x8 a = *(const LAS bf16x8*)(L + O_QT + ((32 * ti + r) * P128 + 16 * s + 8 * hh) * 2), bb = *(const LAS bf16x8*)(L + O_KT + ((32 * xi + r) * P128 + 16 * s + 8 * hh) * 2); acc = MFMA32(a, bb, acc); }
            }
#pragma unroll
            for (int i = 0; i < 16; ++i) { const int t = 32 * ti + (i & 3) + 8 * (i >> 2) + 4 * hh, s = 32 * xi + r; const float v = (s <= t) ? acc[i] : 0.f; *(LAS bf16*)(L + O_SC + (t * P64 + s) * 2) = (bf16)f2bf(v); }
        } else {
#pragma unroll
            for (int s = 0; s < 8; ++s) { const bf16x8 a = *(const LAS bf16x8*)(L + O_QD + ((32 * ti + r) * P128 + 16 * s + 8 * hh) * 2), bb = *(const LAS bf16x8*)(L + O_ST + ((32 * xi + r) * P128 + 16 * s + 8 * hh) * 2); acc = MFMA32(a, bb, acc); }
        }
        __syncthreads();
        if (w >= 4) {
#pragma unroll
            for (int s = 0; s < 4; ++s) { const bf16x8 a = *(const LAS bf16x8*)(L + O_SC + ((32 * ti + r) * P64 + 16 * s + 8 * hh) * 2), bb = vtr8(L + O_VT + vtrs + (16 * s * PV + 32 * xi) * 2); acc = MFMA32(a, bb, acc); }
#pragma unroll
            for (int i = 0; i < 16; ++i) { const int t = 32 * ti + (i & 3) + 8 * (i >> 2) + 4 * hh; *(LAS bf16*)(L + O_OT + (t * P64 + 32 * xi + r) * 2) = (bf16)f2bf(acc[i]); }
        }
        { const LAS float* gp = (const LAS float*)(L + O_G) + 32 * kt_own + 4 * hh;
#pragma unroll
          for (int g = 0; g < 4; ++g) { const f32x4 gv = *(const LAS f32x4*)(gp + 8 * g);
#pragma unroll
              for (int e = 0; e < 4; ++e) sacc[4 * g + e] *= gv[e]; }
#pragma unroll
          for (int s = 0; s < 4; ++s) { const bf16x8 a = *(const LAS bf16x8*)(L + O_KDT + ((32 * kt_own + r) * P64 + 16 * s + 8 * hh) * 2), bb = vtr8(L + O_VT + vtrs + (16 * s * PV + 32 * di_own) * 2); sacc = MFMA32(a, bb, sacc); }
#pragma unroll
          for (int g = 0; g < 4; ++g) *(LAS v2u*)(L + O_ST + ((32 * di_own + r) * P128 + 32 * kt_own + 8 * g + 4 * hh) * 2) = (v2u){pk2(sacc[4 * g], sacc[4 * g + 1]), pk2(sacc[4 * g + 2], sacc[4 * g + 3])}; }
        __syncthreads();
    }
    HG_STORE_O(SEQ / 64 - 1);
#undef HG_LOAD
#undef HG_STORE_O
    __syncthreads();
}
__device__ __forceinline__ void scan_phase(const Ctx& C, const bf16* HQ, const bf16* LOGF, bf16* HI, float* SSQ) {
    for (int it = C.bid; it < NB * NH * 2; it += C.G) { const int half = it & 1, bh = it >> 1; scan_item(C, bh >> 4, bh & 15, half, HQ, LOGF, HI, SSQ); }
}
}
#define XB_TMO      128
#define XB_XCNT(j)  (256  + 64 * (j))
#define XB_XSUB(j)  (1280 + 64 * (j))
#define XB_XGEN(j)  (2304 + 64 * (j))
#define XB_TOP      3328
#define XB_TOPGEN   3392
#define XCD_BAR_WORDS 3456
#define XB_SPIN_CAP (1u << 18)

__device__ __forceinline__ unsigned xb_ld(unsigned* p)              { return __hip_atomic_load(p, __ATOMIC_RELAXED, __HIP_MEMORY_SCOPE_AGENT); }
__device__ __forceinline__ unsigned xb_add(unsigned* p, unsigned v) { return __hip_atomic_fetch_add(p, v, __ATOMIC_RELAXED, __HIP_MEMORY_SCOPE_AGENT); }
__device__ __forceinline__ unsigned xb_xcc_id() { return (unsigned)__builtin_amdgcn_s_getreg((3 << 11) | 20) & 0xFu; }
#define XB_SPIN(cond, bar) do { unsigned _sp = 0; while (cond) { __builtin_amdgcn_s_sleep(1); \
    if ((++_sp & 255u) == 0u) { if (xb_ld(&(bar)[XB_TMO])) break; if (_sp > XB_SPIN_CAP) { atomicAdd(&(bar)[XB_TMO], 1u); break; } } } } while (0)

struct XcdBarrier {
    unsigned* bar; unsigned x;
    volatile LAS unsigned* st;
};

__device__ __forceinline__ XcdBarrier xcd_barrier_post(unsigned* bar, volatile LAS unsigned* st) {
    XcdBarrier b; b.bar = bar; b.x = xb_xcc_id(); b.st = st;
    if (threadIdx.x == 0) (void)xb_add(&bar[XB_XCNT(b.x)], 1u);
    return b;
}
__device__ __forceinline__ void xcd_barrier_complete(unsigned* bar, unsigned x, unsigned& nloc, unsigned& nx) {
    const unsigned G = gridDim.x * gridDim.y * gridDim.z;
    unsigned sum, cnt, mine, sp = 0u;
    for (;;) {
        sum = 0u; cnt = 0u; mine = 0u;
#pragma unroll
        for (unsigned j = 0; j < 16; ++j) { const unsigned c = xb_ld(&bar[XB_XCNT(j)]); sum += c; cnt += (c > 0u) ? 1u : 0u; mine = (j == x) ? c : mine; }
        if (sum == G) break;
        __builtin_amdgcn_s_sleep(1);
        if ((++sp & 255u) == 0u) { if (xb_ld(&bar[XB_TMO])) break; if (sp > XB_SPIN_CAP) { atomicAdd(&bar[XB_TMO], 1u); break; } }
    }
    nloc = mine > 0u ? mine : 1u; nx = cnt > 0u ? cnt : 1u;
}

__device__ __forceinline__ void xcd_barrier(const XcdBarrier& b) {
    asm volatile("s_waitcnt vmcnt(0)" ::: "memory");
    __syncthreads();
    if (threadIdx.x == 0) {
        unsigned* bar = b.bar;
        __builtin_amdgcn_s_waitcnt(0);
        unsigned nloc = b.st[0], nx = b.st[1];
        if (nloc == 0u) { xcd_barrier_complete(bar, b.x, nloc, nx); b.st[0] = nloc; b.st[1] = nx; }
        const unsigned old = xb_add(&bar[XB_XSUB(b.x)], 1u);
        const unsigned gen = old / nloc;
        if (old + 1u == (gen + 1u) * nloc) {
            __builtin_amdgcn_fence(__ATOMIC_RELEASE, "agent");
            asm volatile("s_waitcnt vmcnt(0)" ::: "memory");
            const unsigned og = xb_add(&bar[XB_TOP], 1u);
            const unsigned tg = og / nx;
            if (og + 1u == (tg + 1u) * nx) xb_add(&bar[XB_TOPGEN], 1u);
            else XB_SPIN(xb_ld(&bar[XB_TOPGEN]) == tg, bar);
            __builtin_amdgcn_fence(__ATOMIC_ACQUIRE, "agent");
            xb_add(&bar[XB_XGEN(b.x)], 1u);
            asm volatile("s_waitcnt vmcnt(0)" ::: "memory");
        } else {
            XB_SPIN(xb_ld(&bar[XB_XGEN(b.x)]) == gen, bar);
            __builtin_amdgcn_fence(__ATOMIC_ACQUIRE, "agent");
            asm volatile("s_waitcnt vmcnt(0)" ::: "memory");
        }
    }
    __syncthreads();
}

struct Args { const float* in[24]; float* out; unsigned char* ws; };
template <class Epi> __device__ __forceinline__ void run_gemm(const Ctx& C, const bf16* A, const bf16* Bt, int N, int K, const Epi& E) {
    pg8::Gemm g{A, Bt, T, N, K}; pg8::StaticOrder S; S.init(T, N, C.G, C.bid);
    pg8::gemm_phase<Epi, pg8::StaticOrder, true, true>(C.lds, g, S, E);
}
__global__ void __launch_bounds__(NTHR, 2) mega_fwd(Args a) {
    extern __shared__ __attribute__((aligned(16))) unsigned char lds_raw[];
    cg::grid_group grid = cg::this_grid();
    Ctx C; C.lds = (LAS unsigned char*)lds_raw; C.G = gridDim.x; C.bid = blockIdx.x;
#define FRESH() do { int t_ = threadIdx.x; asm volatile("" : "+v"(t_)); C.tid = t_; C.lane = t_ & 63; C.wave = __builtin_amdgcn_readfirstlane(t_ >> 6); } while (0)
    FRESH();
#define GRID_SYNC() do { asm volatile("s_waitcnt vmcnt(0)" ::: "memory"); __syncthreads(); grid.sync(); if (threadIdx.x < 64) { __builtin_amdgcn_fence(__ATOMIC_ACQUIRE, "agent"); asm volatile("s_waitcnt vmcnt(0)" ::: "memory"); } __syncthreads(); } while (0)
    unsigned char* ws = a.ws; unsigned char* act = ws + WS_ACT;
    unsigned* barw = (unsigned*)(ws + 4096);
    volatile LAS unsigned* bst = (volatile LAS unsigned*)(C.lds + 131072 + 64);
    if (C.tid < 2) bst[C.tid] = 0u;
    if (C.bid == 0) for (int i = C.tid; i < XCD_BAR_WORDS; i += NTHR) barw[i] = 0u;
    __syncthreads();
    XcdBarrier xbar; xbar.bar = barw; xbar.x = 0; xbar.st = bst;
#define XSYNC() do { xcd_barrier(xbar); } while (0)
    const float* x = a.in[0]; const int* pos = (const int*)a.in[1];
    float* LB = (float*)(ws + WS_SMALL + SM_LB); float* COSt = (float*)(ws + WS_SMALL + SM_COS); float* SINt = (float*)(ws + WS_SMALL + SM_SIN);
    bf16* KR = (bf16*)(ws + WS_SMALL + SM_KR); float* SSQ = (float*)(ws + WS_SMALL + SM_SSQ);
    bf16* WGU = (bf16*)(ws + WS_WFFGU); bf16* WD = (bf16*)(ws + WS_WFFD); bf16* WIN = (bf16*)(ws + WS_WIN); bf16* WQ = (bf16*)(ws + WS_WQ); bf16* WKV = (bf16*)(ws + WS_WKV);
    bf16* WMO = (bf16*)(ws + WS_WMO); bf16* WHO = (bf16*)(ws + WS_WHO); bf16* WOUT = (bf16*)(ws + WS_WOUT);
    bf16* HN = (bf16*)(act + A_HN); bf16* ACT1 = (bf16*)(act + A_ACT1); bf16* Y1 = (bf16*)(act + A_Y1);
    bf16* CQKV = (bf16*)(act + A_CQKV); bf16* OA = (bf16*)(act + A_OA); bf16* Qb = (bf16*)(act + A_Q); bf16* KN = (bf16*)(act + A_KN); bf16* VT = (bf16*)(act + A_VT);
    bf16* CQN = (bf16*)(act + A_CQN); bf16* CKVN = (bf16*)(act + A_CKVN);
    bf16* HQ = (bf16*)(act + A_HQ); bf16* LOGF = (bf16*)(act + A_LOGF); bf16* HI = (bf16*)(act + A_HI);
    bf16* GA = (bf16*)(act + A_GA); bf16* GB = (bf16*)(act + A_GB); bf16* Y2 = (bf16*)(act + A_Y2);
    bf16* HN3 = (bf16*)(act + A_HN3); bf16* ACT2 = (bf16*)(act + A_ACT2); bf16* Y3 = (bf16*)(act + A_Y3);
    float* out = a.out;

    conv_ffn(C, a.in[3], a.in[4], a.in[5], WGU, WD);
    conv_mixer(C, a.in[8], a.in[10], a.in[12], a.in[13], a.in[16], a.in[17], WIN, WQ, WKV, WMO, WHO, WOUT);
    rows_norm(C, x, a.in[2], HN);
    { const int i = C.bid * NTHR + C.tid; if (i < 2048) { const float* lg = a.in[14]; LB[i] = fsig(lg[i] - lg[2048 + i]); } }
    GRID_SYNC();
    xbar = xcd_barrier_post(barw, bst);
    run_gemm(C, HN, WGU, 11264, D, pg8::EpiSwiGLU{ACT1, FF});
    XSYNC();
    run_gemm(C, ACT1, WD, D, FF, pg8::EpiBf{Y1, D});
    XSYNC();
    FRESH(); rows_update(C, x, Y1, a.in[6], 0.5f, out, a.in[7], HN);
    FRESH(); conv_ffn(C, a.in[20], a.in[21], a.in[22], WGU, WD);
    XSYNC();
    run_gemm(C, HN, WIN + (size_t)12288 * D, 1280, D, pg8::EpiBf{CQKV, 1280});
    XSYNC();
    FRESH(); rows_latent(C, CQKV, a.in[9], a.in[11], pos, CQN, CKVN, KR, COSt, SINt);
    XSYNC();
    run_gemm(C, CQN, WQ, 3072, 512, pg8::EpiQ{Qb, COSt, SINt, 0.07216878364870322f * 1.4426950408889634f});
    run_gemm(C, CKVN, WKV, 4096, 512, pg8::EpiKV{KN, VT});
    XSYNC();
    att::attn_phase(C, Qb, KN, KR, VT, OA);
    XSYNC();
    run_gemm(C, HN, WIN, 6144, D, pg8::EpiH{HQ, LOGF, HI, LB});
    XSYNC();
    hg::scan_phase(C, HQ, LOGF, HI, SSQ);
    XSYNC();
    run_gemm(C, HN, WIN + (size_t)6144 * D, 2048, D, pg8::EpiHG{HI, SSQ, a.in[15], EPS});
    run_gemm(C, HN, WIN + (size_t)8192 * D, 2048, D, pg8::EpiGate{GA, GA});
    run_gemm(C, OA, WMO, D, D, pg8::EpiMix<0>{GA, GB});
    run_gemm(C, HN, WIN + (size_t)10240 * D, 2048, D, pg8::EpiGate{GB, GB});
    XSYNC();
    run_gemm(C, HI, WHO, D, D, pg8::EpiMix<1>{GA, GB});
    XSYNC();
    run_gemm(C, GB, WOUT, D, D, pg8::EpiBf{Y2, D});
    XSYNC();
    FRESH(); rows_update(C, out, Y2, a.in[18], 1.0f, out, a.in[19], HN3);
    XSYNC();
    run_gemm(C, HN3, WGU, 11264, D, pg8::EpiSwiGLU{ACT2, FF});
    XSYNC();
    run_gemm(C, ACT2, WD, D, FF, pg8::EpiBf{Y3, D});
    XSYNC();
    FRESH(); rows_update(C, out, Y3, a.in[23], 0.5f, out, nullptr, nullptr);
}

extern "C" void kernel_launch(void* const* d_in, const int* in_sizes, int n_in, void* d_out, int out_size, void* d_ws, size_t ws_size, hipStream_t stream) {
    static int grid = 0;
    if (grid == 0) {
        if (n_in != 24 || in_sizes[0] != T * D || out_size != T * D || ws_size < WS_END) { fprintf(stderr, "kernel_launch: unexpected shapes / workspace (n_in %d, ws %zu, need %zu)\n", n_in, ws_size, (size_t)WS_END); grid = -1; return; }
        int dev = 0, cus = 0, per_cu = 0;
        hipGetDevice(&dev); hipDeviceGetAttribute(&cus, hipDeviceAttributeMultiprocessorCount, dev);
        if (hipFuncSetAttribute((const void*)mega_fwd, hipFuncAttributeMaxDynamicSharedMemorySize, LDS_BYTES) != hipSuccess) { fprintf(stderr, "kernel_launch: hipFuncSetAttribute failed\n"); grid = -1; return; }
        if (hipOccupancyMaxActiveBlocksPerMultiprocessor(&per_cu, (const void*)mega_fwd, NTHR, LDS_BYTES) != hipSuccess || per_cu < 1) per_cu = 1;
        (void)hipGetLastError();
        grid = cus * 1;
        if (grid <= 0) grid = 256;
    }
    if (grid < 0) return;
    Args a{};
    for (int i = 0; i < 24; ++i) a.in[i] = (const float*)d_in[i];
    a.out = (float*)d_out; a.ws = (unsigned char*)d_ws;
    void* args[] = {&a};
    hipError_t e = hipLaunchCooperativeKernel((const void*)mega_fwd, dim3(grid), dim3(NTHR), args, LDS_BYTES, stream);
    if (e != hipSuccess) fprintf(stderr, "cooperative launch failed: %s (grid %d)\n", hipGetErrorString(e), grid);
}
```
